# Optimizing an MI355X kernel written in HIP

```python
import jax, jax.numpy as jnp
from jax import lax
import numpy as np

D_MODEL = 1024
BATCH = 4
SEQ = 8192
DEPTH = 1

RET_HEADS = 4
RET_QK_DIM = 128
RET_V_DIM = 256
RET_CHUNK = 128
ATTN_Q_HEADS = 16
ATTN_KV_HEADS = 2
ATTN_HEAD_DIM = 64
WINDOW = 128
ATTN_BLOCK = 128
D_FF = -(-8 * D_MODEL // (3 * 256)) * 256
ROPE_THETA = 10000.0
EPS = 1e-6

RET_QK = RET_HEADS * RET_QK_DIM
RET_V = RET_HEADS * RET_V_DIM
ATTN_Q = ATTN_Q_HEADS * ATTN_HEAD_DIM
ATTN_KV = ATTN_KV_HEADS * ATTN_HEAD_DIM
SPLITS = [RET_QK, RET_QK, RET_V, RET_V, ATTN_Q, ATTN_KV, ATTN_KV, D_MODEL, D_MODEL]
D_IN = sum(SPLITS)
SPLIT_IDX = [int(v) for v in np.cumsum(SPLITS)[:-1]]

kernel_name = "hybrid_retention_swa_sink_gated_block"


def rms_norm(x, g):
    xf = x.astype(jnp.float32)
    y = xf * lax.rsqrt(jnp.mean(xf * xf, axis=-1, keepdims=True) + EPS)
    return (y * g.astype(jnp.float32)).astype(x.dtype)


def rotary(x, pos):
    d = x.shape[-1]
    half = d // 2
    inv_freq = ROPE_THETA ** (-jnp.arange(half, dtype=jnp.float32) / half)
    ang = pos.astype(jnp.float32)[:, None] * inv_freq[None, :]
    cos = jnp.cos(ang)[None, :, None, :]
    sin = jnp.sin(ang)[None, :, None, :]
    xf = x.astype(jnp.float32)
    x1, x2 = xf[..., :half], xf[..., half:]
    out = jnp.concatenate([x1 * cos - x2 * sin, x2 * cos + x1 * sin], axis=-1)
    return out.astype(x.dtype)


def retention_chunkwise(q, k, v):
    B, S, H, dk = q.shape
    dv = v.shape[-1]
    C = RET_CHUNK
    N = S // C
    log_gamma = jnp.log1p(-jnp.exp2(-5.0 - jnp.arange(H, dtype=jnp.float32)))
    idx = jnp.arange(C, dtype=jnp.float32)
    rel = idx[:, None] - idx[None, :]
    intra_decay = jnp.where(rel[None] >= 0,
                            jnp.exp(log_gamma[:, None, None] * jnp.maximum(rel, 0.0)[None]), 0.0)
    q_decay = jnp.exp(log_gamma[:, None] * (idx + 1.0))[None, :, :, None]
    k_decay = jnp.exp(log_gamma[:, None] * (C - 1.0 - idx))[None, :, :, None]
    chunk_decay = jnp.exp(log_gamma * C)[None, :, None, None]

    qf = q.astype(jnp.float32) * (dk ** -0.5)
    kf = k.astype(jnp.float32)
    vf = v.astype(jnp.float32)
    to_chunks = lambda t: t.reshape(B, N, C, H, t.shape[-1]).transpose(1, 0, 3, 2, 4)
    qc, kc, vc = to_chunks(qf), to_chunks(kf), to_chunks(vf)

    def step(state, inp):
        qn, kn, vn = inp
        scores = jnp.einsum('bhcd,bhsd->bhcs', qn, kn) * intra_decay
        inner = jnp.einsum('bhcs,bhse->bhce', scores, vn)
        cross = jnp.einsum('bhcd,bhde->bhce', qn, state) * q_decay
        new_state = state * chunk_decay + jnp.einsum('bhsd,bhse->bhde', kn * k_decay, vn)
        return new_state, inner + cross

    state0 = jnp.zeros((B, H, dk, dv), jnp.float32)
    _, out = lax.scan(step, state0, (qc, kc, vc))
    return out.transpose(1, 0, 3, 2, 4).reshape(B, S, H, dv)


def head_group_norm(y, g):
    B, S, H, dv = y.shape
    mu = jnp.mean(y, axis=-1, keepdims=True)
    yc = y - mu
    var = jnp.mean(yc * yc, axis=-1, keepdims=True)
    yn = (yc * lax.rsqrt(var + EPS)).reshape(B, S, H * dv)
    return yn * g.astype(jnp.float32)


def sliding_window_sink_attention(q, k, v, sinks):
    B, S, Hq, d = q.shape
    Hkv = k.shape[2]
    G = Hq // Hkv
    C = ATTN_BLOCK
    N = S // C
    qb = q.reshape(B, N, C, Hkv, G, d)
    pad = ((0, 0), (C, 0), (0, 0), (0, 0))
    kp = jnp.pad(k, pad).reshape(B, N + 1, C, Hkv, d)
    vp = jnp.pad(v, pad).reshape(B, N + 1, C, Hkv, d)
    kb = jnp.concatenate([kp[:, :-1], kp[:, 1:]], axis=2)
    vb = jnp.concatenate([vp[:, :-1], vp[:, 1:]], axis=2)
    scores = jnp.einsum('bnqhgd,bnkhd->bnhgqk', qb, kb).astype(jnp.float32) * (d ** -0.5)
    qi = jnp.arange(C)[:, None]
    kj = jnp.arange(2 * C)[None, :]
    rel = C + qi - kj
    key_pos = jnp.arange(N)[:, None, None] * C + kj[None] - C
    mask = (rel[None] >= 0) & (rel[None] < WINDOW) & (key_pos >= 0)
    scores = jnp.where(mask[None, :, None, None], scores, -1e30)
    sink = sinks.astype(jnp.float32).reshape(1, 1, Hkv, G, 1, 1)
    m = jnp.maximum(jnp.max(scores, axis=-1, keepdims=True), sink)
    e = jnp.exp(scores - m)
    probs = e / (jnp.sum(e, axis=-1, keepdims=True) + jnp.exp(sink - m))
    out = jnp.einsum('bnhgqk,bnkhd->bnqhgd', probs.astype(v.dtype), vb)
    return out.reshape(B, S, Hq, d)


def setup_inputs(seed: int = 0) -> dict:
    key = jax.random.key(seed)
    ks = jax.random.split(key, 16)
    nrm = lambda k, shape, fan_in: jax.random.normal(k, shape, jnp.float32) * (fan_in ** -0.5)
    gain = lambda k, shape: 1.0 + 0.02 * jax.random.normal(k, shape, jnp.float32)
    return {
        "x": jax.random.normal(ks[0], (BATCH, SEQ, D_MODEL), jnp.float32),
        "ln1_g": gain(ks[1], (DEPTH, D_MODEL)),
        "w_in": nrm(ks[2], (DEPTH, D_MODEL, D_IN), D_MODEL),
        "b_in": 0.02 * jax.random.normal(ks[3], (DEPTH, D_IN), jnp.float32),
        "ret_norm_g": gain(ks[4], (DEPTH, RET_V)),
        "w_ret_out": nrm(ks[5], (DEPTH, RET_V, D_MODEL), RET_V),
        "attn_sinks": 0.5 * jax.random.normal(ks[6], (DEPTH, ATTN_Q_HEADS), jnp.float32),
        "w_attn_out": nrm(ks[7], (DEPTH, ATTN_Q, D_MODEL), ATTN_Q),
        "w_out": nrm(ks[8], (DEPTH, D_MODEL, D_MODEL), D_MODEL),
        "ln2_g": gain(ks[9], (DEPTH, D_MODEL)),
        "w_ffn_gate": nrm(ks[10], (DEPTH, D_MODEL, D_FF), D_MODEL),
        "w_ffn_up": nrm(ks[11], (DEPTH, D_MODEL, D_FF), D_MODEL),
        "w_ffn_down": nrm(ks[12], (DEPTH, D_FF, D_MODEL), D_FF),
        "lnf_g": gain(ks[13], (D_MODEL,)),
    }


def reference(x, ln1_g, w_in, b_in, ret_norm_g, w_ret_out, attn_sinks, w_attn_out, w_out,
              ln2_g, w_ffn_gate, w_ffn_up, w_ffn_down, lnf_g):
    B, S, _ = x.shape
    pos = jnp.arange(S, dtype=jnp.int32)
    for l in range(DEPTH):
        h = rms_norm(x, ln1_g[l])
        proj = h @ w_in[l] + b_in[l]
        rq, rk, rv, rg, aq, ak, av, gate_a, gate_b = jnp.split(proj, SPLIT_IDX, axis=-1)

        rq = rotary(rq.reshape(B, S, RET_HEADS, RET_QK_DIM), pos)
        rk = rotary(rk.reshape(B, S, RET_HEADS, RET_QK_DIM), pos)
        ry = retention_chunkwise(rq, rk, rv.reshape(B, S, RET_HEADS, RET_V_DIM))
        ry = head_group_norm(ry, ret_norm_g[l]).astype(x.dtype)
        branch_a = (jax.nn.silu(rg) * ry) @ w_ret_out[l]

        aq = rotary(aq.reshape(B, S, ATTN_Q_HEADS, ATTN_HEAD_DIM), pos)
        ak = rotary(ak.reshape(B, S, ATTN_KV_HEADS, ATTN_HEAD_DIM), pos)
        ay = sliding_window_sink_attention(aq, ak, av.reshape(B, S, ATTN_KV_HEADS, ATTN_HEAD_DIM),
                                           attn_sinks[l])
        branch_b = ay.reshape(B, S, ATTN_Q) @ w_attn_out[l]

        merged = jax.nn.sigmoid(gate_a) * branch_a + jax.nn.sigmoid(gate_b) * branch_b
        x = x + merged @ w_out[l]

        h2 = rms_norm(x, ln2_g[l])
        x = x + (jax.nn.silu(h2 @ w_ffn_gate[l]) * (h2 @ w_ffn_up[l])) @ w_ffn_down[l]
    return rms_norm(x, lnf_g)
```

```cpp
#include <hip/hip_runtime.h>
#include <cstdio>
#include <cstdint>

#ifndef MK_N_LAUNCHES
#define MK_N_LAUNCHES 1
#endif

constexpr int NB = 4, SEQ = 8192, D = 1024, M = NB * SEQ;
constexpr int DIN = 6400, DFF = 2816, NGU = 2 * DFF;
constexpr int RH = 4, RDK = 128, RDV = 256, RC = 128, NCH = SEQ / RC;
constexpr int AH = 16, AKV = 2, AD = 64, AWIN = 128;
constexpr float EPS = 1e-6f;

#define LAS __attribute__((address_space(3)))
#define GAS __attribute__((address_space(1)))
typedef unsigned short bf16_t;
typedef short bf16x8 __attribute__((ext_vector_type(8)));
typedef float f32x4 __attribute__((ext_vector_type(4)));
typedef float f32x2 __attribute__((ext_vector_type(2)));
typedef unsigned u32x4 __attribute__((ext_vector_type(4)));
typedef unsigned u32x2 __attribute__((ext_vector_type(2)));
typedef GAS unsigned gu32;

__device__ __forceinline__ unsigned cvt_pk_bf16(float lo, float hi) { unsigned r; asm volatile("v_cvt_pk_bf16_f32 %0, %1, %2" : "=v"(r) : "v"(lo), "v"(hi)); return r; }
__device__ __forceinline__ float bf_lo(unsigned w) { return __uint_as_float(w << 16); }
__device__ __forceinline__ float bf_hi(unsigned w) { return __uint_as_float(w & 0xffff0000u); }
__device__ __forceinline__ float bf2f(bf16_t v) { return __uint_as_float((unsigned)v << 16); }
__device__ __forceinline__ unsigned f2bf(float f) { unsigned u = __builtin_bit_cast(unsigned, f); return (u + 0x7fffu + ((u >> 16) & 1u)) >> 16; }
__device__ __forceinline__ unsigned pk2(float lo, float hi) { return f2bf(lo) | (f2bf(hi) << 16); }
__device__ __forceinline__ float sigmoidf_(float v) { return 1.0f / (1.0f + __expf(-v)); }
__device__ __forceinline__ float wave_sum(float v) {
#pragma unroll
    for (int o = 1; o < 64; o <<= 1) v += __shfl_xor(v, o);
    return v;
}
__device__ __forceinline__ float wave_max(float v) {
#pragma unroll
    for (int o = 1; o < 64; o <<= 1) v = fmaxf(v, __shfl_xor(v, o));
    return v;
}

constexpr size_t MiB = 1u << 20;
constexpr size_t WS_CTL = 0, CTL_ZERO_BYTES = 64 * 1024;
constexpr size_t WS_W1 = 1 * MiB;
constexpr size_t WS_WR = 14 * MiB;
constexpr size_t WS_WA = 16 * MiB;
constexpr size_t WS_WO = 18 * MiB;
constexpr size_t WS_WGU = 20 * MiB;
constexpr size_t WS_WD = 31 * MiB;
constexpr size_t WS_COSR = 37 * MiB, WS_SINR = 39 * MiB, WS_COSA = 41 * MiB, WS_SINA = 42 * MiB;
constexpr size_t WS_RS = 43 * MiB;
constexpr size_t WS_RQ = 48 * MiB;
constexpr size_t WS_RK = 80 * MiB;
constexpr size_t WS_RV = 112 * MiB;
constexpr size_t WS_RG = 176 * MiB;
constexpr size_t WS_AQ = 240 * MiB;
constexpr size_t WS_AK = 304 * MiB;
constexpr size_t WS_AV = 312 * MiB;
constexpr size_t WS_GA = 320 * MiB;
constexpr size_t WS_GB = 384 * MiB;
constexpr size_t WS_END = 448 * MiB;
constexpr size_t WS_MG = WS_RQ;
constexpr size_t WS_X1B = WS_RV;
constexpr size_t WS_ACT = WS_RG;
static_assert(WS_ACT + (size_t)M * DFF * 2 <= WS_END, "act overlay");

constexpr int CW_TMO = 0, CW_CODE = 1, CW_BAR = 1024;

namespace pg8 {
#define PG8_LAS __attribute__((address_space(3)))
constexpr int BM = 256, BK = 64, HALF = 128, HTB = HALF * BK * 2, STAGE_BYTES = 8 * HTB, NXCD = 8, WGM = 8;
__host__ __device__ __forceinline__ int lds_byte(int r, int c) { const int st = (r >> 4) * 2 + (c >> 5), rr = r & 15, cc = c & 31, ob = rr * 64 + cc * 2; return st * 1024 + (ob ^ (((ob >> 9) & 1) << 5)); }
__host__ __device__ __forceinline__ void stage_rc(int b, int& R, int& C) { const int st = b / 1024, sb = b % 1024, swz = sb ^ (((sb >> 9) & 1) << 5); R = (st >> 1) * 16 + swz / 64; C = (st & 1) * 32 + (swz % 64) / 2; }

struct Unit { int pm, pn, sel; };
struct Gemm { const bf16_t* A0; const bf16_t* B0; const bf16_t* A1; const bf16_t* B1; int K; };

struct StaticOrder {
    int nM, nN, nwg, G, c;
    __device__ void init(int M_, int N_, int G_, int c_) { nM = M_ / BM; nN = N_ / BM; nwg = nM * nN; G = G_; c = c_; }
    __device__ bool tile(int i, Unit& u) const {
        const long L = (long)i * G + c; if (L >= nwg) return false;
        int wgid = (int)L; { const int q = nwg / NXCD, r = nwg % NXCD, xcd = wgid % NXCD, off = wgid / NXCD; wgid = (xcd < r ? xcd * (q + 1) : r * (q + 1) + (xcd - r) * q) + off; }
        const int nig = WGM * nN, gid = wgid / nig, fm = gid * WGM, gsz = (nM - fm) < WGM ? (nM - fm) : WGM;
        u.pm = fm + ((wgid % nig) % gsz); u.pn = (wgid % nig) / gsz; u.sel = 0; return true;
    }
    __device__ bool next(int i, Unit& u) const { return tile(i, u); }
};
struct DualOrder : StaticOrder {
    __device__ bool next(int i, Unit& u) const { if (!tile(i >> 1, u)) return false; u.sel = i & 1; return true; }
};

template <class Epi, class Sched, bool ALIGN_EPI, bool SP2>
__device__ __forceinline__ void gemm_phase(PG8_LAS unsigned char* lds, const Gemm g, const Sched& S, const Epi& E) {
    const int tid = threadIdx.x, wid = __builtin_amdgcn_readfirstlane(tid >> 6), lane = tid & 63, wr = wid >> 2, wc = wid & 3, fr = lane & 15, fq = lane >> 4;
    const int K = g.K, nt = K / BK;
    unsigned voffA[2];
#pragma unroll
    for (int i = 0; i < 2; ++i) { int R, C; stage_rc(tid * 16 + i * 8192, R, C); voffA[i] = (unsigned)(R * K + C) * 2u; }
    const size_t kstep = (size_t)(BK * 2);
    const size_t hstep = (size_t)HALF * K * 2;
    const size_t tstep = 2 * hstep;
    const unsigned ldsw = (unsigned)wid * 1024u;
    const int aoff = lds_byte(wr * 64 + fr, fq * 8), boff = lds_byte(wc * 32 + fr, fq * 8);
#define PG8_SA(b, h) (((b) * 2 + (h)) * HTB)
#define PG8_SB(b, h) ((4 + (b) * 2 + (h)) * HTB)
#define PG8_STAGE(bufoff, gbase) do { _Pragma("unroll") for (int _i = 0; _i < 2; ++_i) \
        __builtin_amdgcn_global_load_lds((const unsigned*)((const char*)(gbase) + voffA[_i]), (PG8_LAS unsigned*)(lds + (bufoff) + ldsw + _i * 8192), 16, 0, 0); } while (0)
#define PG8_LDA(dst, b, h) do { _Pragma("unroll") for (int m = 0; m < 4; ++m) _Pragma("unroll") for (int k = 0; k < 2; ++k) dst[m][k] = *(const PG8_LAS bf16x8*)(lds + PG8_SA(b, h) + aoff + m * 2048 + k * 1024); } while (0)
#define PG8_LDB(dst, b, h) do { _Pragma("unroll") for (int n = 0; n < 2; ++n) _Pragma("unroll") for (int k = 0; k < 2; ++k) dst[n][k] = *(const PG8_LAS bf16x8*)(lds + PG8_SB(b, h) + boff + n * 2048 + k * 1024); } while (0)
#define PG8_MMA(ai, bj, At, Bt) do { __builtin_amdgcn_s_setprio(1); _Pragma("unroll") for (int m = 0; m < 4; ++m) _Pragma("unroll") for (int n = 0; n < 2; ++n) _Pragma("unroll") for (int k = 0; k < 2; ++k) \
        acc[ai][bj][m][n] = __builtin_amdgcn_mfma_f32_16x16x32_bf16(Bt[n][k], At[m][k], acc[ai][bj][m][n], 0, 0, 0); __builtin_amdgcn_s_setprio(0); } while (0)
#define PG8_WAIT_V(n) asm volatile("s_waitcnt vmcnt(" #n ")" ::: "memory")
#define PG8_WAIT_L(n) asm volatile("s_waitcnt lgkmcnt(" #n ")" ::: "memory")
#define PG8_BAR __builtin_amdgcn_s_barrier()
#define PG8_SCHED __builtin_amdgcn_sched_barrier(0)
#define PG8_ABASE(u) ((const char*)((u).sel ? g.A1 : g.A0) + (size_t)(u).pm * tstep)
#define PG8_BBASE(u) ((const char*)((u).sel ? g.B1 : g.B0) + (size_t)(u).pn * tstep)
    Unit cur, nxt; int ui = 0;
    if (!S.next(0, cur)) return;
    f32x4 acc[2][2][4][2];
#pragma unroll
    for (int a = 0; a < 2; ++a)
#pragma unroll
        for (int b = 0; b < 2; ++b)
#pragma unroll
            for (int m = 0; m < 4; ++m)
#pragma unroll
                for (int n = 0; n < 2; ++n) acc[a][b][m][n] = (f32x4){0.f, 0.f, 0.f, 0.f};
    bf16x8 At[4][2], B0[2][2], B1[2][2];
    const char* cA = PG8_ABASE(cur); const char* cB = PG8_BBASE(cur);
    if constexpr (SP2) {
        PG8_STAGE(PG8_SB(0, 0), cB); PG8_STAGE(PG8_SB(0, 1), cB + hstep); PG8_STAGE(PG8_SA(0, 0), cA); PG8_STAGE(PG8_SA(0, 1), cA + hstep);
        if (wr == 1) PG8_BAR;
        PG8_WAIT_V(2); PG8_BAR;
        PG8_STAGE(PG8_SB(1, 0), cB + kstep); PG8_STAGE(PG8_SA(1, 0), cA + kstep); PG8_STAGE(PG8_SB(1, 1), cB + hstep + kstep);
        PG8_WAIT_V(6); PG8_BAR;
    } else {
        PG8_STAGE(PG8_SB(0, 0), cB); PG8_STAGE(PG8_SA(0, 0), cA); PG8_STAGE(PG8_SB(0, 1), cB + hstep); PG8_STAGE(PG8_SA(0, 1), cA + hstep);
        if (wr == 1) PG8_BAR;
        PG8_WAIT_V(4); PG8_BAR;
        PG8_STAGE(PG8_SB(1, 0), cB + kstep); PG8_STAGE(PG8_SA(1, 0), cA + kstep); PG8_STAGE(PG8_SB(1, 1), cB + hstep + kstep);
        PG8_WAIT_V(6); PG8_BAR;
    }
    for (;;) {
        const bool has_next = S.next(ui + 1, nxt);
        const char* nA = has_next ? PG8_ABASE(nxt) : cA; const char* nB = has_next ? PG8_BBASE(nxt) : cB;
        for (int t = 0; t < nt; t += 2) {
            const bool last = (t == nt - 2);
            const char* a1 = cA + (size_t)(t + 1) * kstep;
            const char* a2 = last ? nA : cA + (size_t)(t + 2) * kstep; const char* b2 = last ? nB : cB + (size_t)(t + 2) * kstep;
            const char* a3 = a2 + kstep; const char* b3 = b2 + kstep;
            if constexpr (SP2) {
            PG8_LDB(B0, 0, 0); PG8_LDB(B1, 0, 1); PG8_SCHED; PG8_LDA(At, 0, 0); PG8_STAGE(PG8_SA(1, 1), a1 + hstep);
            PG8_WAIT_V(8); PG8_WAIT_L(0); PG8_BAR; PG8_MMA(0, 0, At, B0); PG8_MMA(0, 1, At, B1); PG8_BAR; PG8_SCHED;
            PG8_LDA(At, 0, 1); PG8_STAGE(PG8_SB(0, 0), b2); PG8_STAGE(PG8_SB(0, 1), b2 + hstep); PG8_STAGE(PG8_SA(0, 0), a2);
            PG8_WAIT_V(8); PG8_WAIT_L(0); PG8_BAR; PG8_MMA(1, 0, At, B0); PG8_MMA(1, 1, At, B1); PG8_BAR; PG8_SCHED;
            PG8_LDB(B0, 1, 0); PG8_LDB(B1, 1, 1); PG8_SCHED; PG8_LDA(At, 1, 0); PG8_STAGE(PG8_SA(0, 1), a2 + hstep);
            PG8_WAIT_V(8); PG8_WAIT_L(0); PG8_BAR; PG8_MMA(0, 0, At, B0); PG8_MMA(0, 1, At, B1); PG8_BAR; PG8_SCHED;
            PG8_LDA(At, 1, 1); PG8_STAGE(PG8_SB(1, 0), b3); PG8_STAGE(PG8_SB(1, 1), b3 + hstep); PG8_STAGE(PG8_SA(1, 0), a3);
            PG8_WAIT_V(8); PG8_WAIT_L(0); PG8_BAR; PG8_MMA(1, 0, At, B0); PG8_MMA(1, 1, At, B1); PG8_BAR; PG8_SCHED;
            } else {
            PG8_LDB(B0, 0, 0); PG8_SCHED; PG8_LDA(At, 0, 0); PG8_STAGE(PG8_SA(1, 1), a1 + hstep);
            PG8_WAIT_L(8); PG8_BAR; PG8_WAIT_L(0); PG8_MMA(0, 0, At, B0); PG8_BAR; PG8_SCHED;
            PG8_LDB(B1, 0, 1); PG8_STAGE(PG8_SB(0, 0), b2);
            PG8_BAR; PG8_WAIT_L(0); PG8_MMA(0, 1, At, B1); PG8_BAR;
            PG8_LDA(At, 0, 1); PG8_STAGE(PG8_SA(0, 0), a2);
            PG8_BAR; PG8_WAIT_L(0); PG8_MMA(1, 0, At, B0); PG8_BAR; PG8_SCHED;
            PG8_STAGE(PG8_SB(0, 1), b2 + hstep);
            PG8_WAIT_V(6); PG8_BAR; PG8_MMA(1, 1, At, B1); PG8_BAR;
            PG8_LDB(B0, 1, 0); PG8_SCHED; PG8_LDA(At, 1, 0); PG8_STAGE(PG8_SA(0, 1), a2 + hstep);
            PG8_WAIT_L(8); PG8_BAR; PG8_WAIT_L(0); PG8_MMA(0, 0, At, B0); PG8_BAR; PG8_SCHED;
            PG8_LDB(B1, 1, 1); PG8_STAGE(PG8_SB(1, 0), b3);
            PG8_BAR; PG8_WAIT_L(0); PG8_MMA(0, 1, At, B1); PG8_BAR;
            PG8_LDA(At, 1, 1); PG8_STAGE(PG8_SA(1, 0), a3);
            PG8_BAR; PG8_WAIT_L(0); PG8_MMA(1, 0, At, B0); PG8_BAR; PG8_SCHED;
            PG8_STAGE(PG8_SB(1, 1), b3 + hstep);
            PG8_WAIT_V(6); PG8_BAR; PG8_MMA(1, 1, At, B1); PG8_BAR;
            }
        }
        if constexpr (ALIGN_EPI) { if (wr == 0) PG8_BAR; }
        E(acc, cur, wr, wc, fr, fq);
        if (!has_next) break;
#pragma unroll
        for (int a = 0; a < 2; ++a)
#pragma unroll
            for (int b = 0; b < 2; ++b)
#pragma unroll
                for (int m = 0; m < 4; ++m)
#pragma unroll
                    for (int n = 0; n < 2; ++n) acc[a][b][m][n] = (f32x4){0.f, 0.f, 0.f, 0.f};
        cur = nxt; cA = nA; cB = nB; ++ui;
        if constexpr (ALIGN_EPI) { if (wr == 1) PG8_BAR; }
    }
    PG8_WAIT_V(0);
    if constexpr (!ALIGN_EPI) { if (wr == 0) PG8_BAR; }
    PG8_BAR;
#undef PG8_SA
#undef PG8_SB
#undef PG8_STAGE
#undef PG8_LDA
#undef PG8_LDB
#undef PG8_MMA
#undef PG8_WAIT_V
#undef PG8_WAIT_L
#undef PG8_BAR
#undef PG8_SCHED
#undef PG8_ABASE
#undef PG8_BBASE
}
}

typedef f32x4 acc_t[2][2][4][2];

struct Ptrs {
    const float* x; const float* b_in; const float* rg_g; const float* sinks; const float* lnf_g;
    float* out; unsigned char* ws;
};
__device__ __forceinline__ void ld8(const float* p, float (&v)[8]) { const f32x4 a = *(const f32x4*)p, b = *(const f32x4*)(p + 4); v[0] = a[0]; v[1] = a[1]; v[2] = a[2]; v[3] = a[3]; v[4] = b[0]; v[5] = b[1]; v[6] = b[2]; v[7] = b[3]; }
__device__ __forceinline__ void ldbf8(const bf16_t* p, float (&v)[8]) { const u32x4 w = *(const u32x4*)p; v[0] = bf_lo(w.x); v[1] = bf_hi(w.x); v[2] = bf_lo(w.y); v[3] = bf_hi(w.y); v[4] = bf_lo(w.z); v[5] = bf_hi(w.z); v[6] = bf_lo(w.w); v[7] = bf_hi(w.w); }
__device__ __forceinline__ void st8(bf16_t* p, const float (&v)[8]) { u32x4 w; w.x = cvt_pk_bf16(v[0], v[1]); w.y = cvt_pk_bf16(v[2], v[3]); w.z = cvt_pk_bf16(v[4], v[5]); w.w = cvt_pk_bf16(v[6], v[7]); *(u32x4*)p = w; }
__device__ __forceinline__ void acc8(const acc_t& acc, int ai, int bj, int m, float (&v)[8]) { const f32x4 a = acc[ai][bj][m][0], b = acc[ai][bj][m][1]; v[0] = a[0]; v[1] = a[1]; v[2] = a[2]; v[3] = a[3]; v[4] = b[0]; v[5] = b[1]; v[6] = b[2]; v[7] = b[3]; }

struct Epi1 {
    Ptrs P;
    __device__ __forceinline__ void operator()(const acc_t& acc, const pg8::Unit& u, int wr, int wc, int fr, int fq) const {
        unsigned char* ws = P.ws; const int pn = u.pn; const int rowb = u.pm * 256 + wr * 64 + fr;
        const float* bias = P.b_in;
        if (pn < 4) {
            const int hd2 = wc >> 1, i0 = (wc & 1) * 32 + fq * 8, natc = pn * 256 + hd2 * 128 + i0;
            float b1[8], b2[8]; ld8(bias + natc, b1); ld8(bias + natc + 64, b2);
            const float sc = pn < 2 ? 0.08838834764831845f : 1.0f;
            bf16_t* outp = (bf16_t*)(ws + (pn < 2 ? WS_RQ : WS_RK)); const int oc = (pn & 1) * 256 + hd2 * 128 + i0;
            const float* cosT = (const float*)(ws + WS_COSR); const float* sinT = (const float*)(ws + WS_SINR);
#pragma unroll
            for (int ai = 0; ai < 2; ++ai)
#pragma unroll
                for (int m = 0; m < 4; ++m) {
                    const int row = rowb + ai * 128 + m * 16, pos = row & (SEQ - 1);
                    float c[8], s[8], x1[8], x2[8], o1[8], o2[8]; ld8(cosT + pos * 64 + i0, c); ld8(sinT + pos * 64 + i0, s); acc8(acc, ai, 0, m, x1); acc8(acc, ai, 1, m, x2);
#pragma unroll
                    for (int j = 0; j < 8; ++j) { const float a = x1[j] + b1[j], b = x2[j] + b2[j]; o1[j] = (a * c[j] - b * s[j]) * sc; o2[j] = (b * c[j] + a * s[j]) * sc; }
                    st8(outp + (size_t)row * 512 + oc, o1); st8(outp + (size_t)row * 512 + oc + 64, o2);
                }
        } else if (pn >= 12 && pn < 16) {
            const int i0 = fq * 8, natc = pn * 256 + wc * 64 + i0;
            float b1[8], b2[8]; ld8(bias + natc, b1); ld8(bias + natc + 32, b2);
            bf16_t* outp = (bf16_t*)(ws + WS_AQ); const int oc = (pn - 12) * 256 + wc * 64 + i0;
            const float* cosT = (const float*)(ws + WS_COSA); const float* sinT = (const float*)(ws + WS_SINA);
#pragma unroll
            for (int ai = 0; ai < 2; ++ai)
#pragma unroll
                for (int m = 0; m < 4; ++m) {
                    const int row = rowb + ai * 128 + m * 16, pos = row & (SEQ - 1);
                    float c[8], s[8], x1[8], x2[8], o1[8], o2[8]; ld8(cosT + pos * 32 + i0, c); ld8(sinT + pos * 32 + i0, s); acc8(acc, ai, 0, m, x1); acc8(acc, ai, 1, m, x2);
#pragma unroll
                    for (int j = 0; j < 8; ++j) { const float a = x1[j] + b1[j], b = x2[j] + b2[j]; o1[j] = (a * c[j] - b * s[j]) * 0.125f; o2[j] = (b * c[j] + a * s[j]) * 0.125f; }
                    st8(outp + (size_t)row * 1024 + oc, o1); st8(outp + (size_t)row * 1024 + oc + 32, o2);
                }
        } else if (pn == 16) {
            const int hd = wc >> 1, i0 = (wc & 1) * 16 + fq * 4;
            const f32x4 b1 = *(const f32x4*)(bias + 4096 + hd * 64 + i0), b2 = *(const f32x4*)(bias + 4096 + hd * 64 + 32 + i0);
            float bv[8]; ld8(bias + 4224 + wc * 32 + fq * 8, bv);
            bf16_t* ak = (bf16_t*)(ws + WS_AK); bf16_t* av = (bf16_t*)(ws + WS_AV);
            const float* cosT = (const float*)(ws + WS_COSA); const float* sinT = (const float*)(ws + WS_SINA);
#pragma unroll
            for (int ai = 0; ai < 2; ++ai)
#pragma unroll
                for (int m = 0; m < 4; ++m) {
                    const int row = rowb + ai * 128 + m * 16, pos = row & (SEQ - 1);
                    const f32x4 c = *(const f32x4*)(cosT + pos * 32 + i0), s = *(const f32x4*)(sinT + pos * 32 + i0);
                    const f32x4 a = acc[ai][0][m][0] + b1, b = acc[ai][0][m][1] + b2;
                    const f32x4 o1 = a * c - b * s, o2 = b * c + a * s;
                    u32x2 w1, w2; w1.x = cvt_pk_bf16(o1[0], o1[1]); w1.y = cvt_pk_bf16(o1[2], o1[3]); w2.x = cvt_pk_bf16(o2[0], o2[1]); w2.y = cvt_pk_bf16(o2[2], o2[3]);
                    *(u32x2*)(ak + (size_t)row * 128 + hd * 64 + i0) = w1; *(u32x2*)(ak + (size_t)row * 128 + hd * 64 + 32 + i0) = w2;
                    float v[8]; acc8(acc, ai, 1, m, v);
#pragma unroll
                    for (int j = 0; j < 8; ++j) v[j] += bv[j];
                    st8(av + (size_t)row * 128 + wc * 32 + fq * 8, v);
                }
        } else {
            int act, ocb; bf16_t* outp;
            if (pn < 8) { act = 0; outp = (bf16_t*)(ws + WS_RV); ocb = (pn - 4) * 256; }
            else if (pn < 12) { act = 1; outp = (bf16_t*)(ws + WS_RG); ocb = (pn - 8) * 256; }
            else if (pn < 21) { act = 2; outp = (bf16_t*)(ws + WS_GA); ocb = (pn - 17) * 256; }
            else { act = 2; outp = (bf16_t*)(ws + WS_GB); ocb = (pn - 21) * 256; }
            const int c8 = wc * 32 + fq * 8;
#pragma unroll
            for (int bj = 0; bj < 2; ++bj) {
                float bv[8]; ld8(bias + pn * 256 + bj * 128 + c8, bv);
#pragma unroll
                for (int ai = 0; ai < 2; ++ai)
#pragma unroll
                    for (int m = 0; m < 4; ++m) {
                        const int row = rowb + ai * 128 + m * 16; float v[8]; acc8(acc, ai, bj, m, v);
#pragma unroll
                        for (int j = 0; j < 8; ++j) { float t = v[j] + bv[j]; const float sg = sigmoidf_(t); v[j] = act == 0 ? t : (act == 1 ? t * sg : sg); }
                        st8(outp + (size_t)row * 1024 + ocb + bj * 128 + c8, v);
                    }
            }
        }
    }
};

struct Epi2 {
    Ptrs P;
    __device__ __forceinline__ void operator()(const acc_t& acc, const pg8::Unit& u, int wr, int wc, int fr, int fq) const {
        unsigned char* ws = P.ws; const int rowb = u.pm * 256 + wr * 64 + fr, c8 = u.pn * 256 + wc * 32 + fq * 8;
        u32x4* pt = (u32x4*)((unsigned char*)P.out + (size_t)(u.pm * 4 + u.pn) * 131072) + threadIdx.x;
        const bf16_t* gate = (const bf16_t*)(ws + (u.sel ? WS_GB : WS_GA));
        bf16_t* mg = (bf16_t*)(ws + WS_MG);
#pragma unroll
        for (int ai = 0; ai < 2; ++ai)
#pragma unroll
            for (int m = 0; m < 4; ++m)
#pragma unroll
                for (int bj = 0; bj < 2; ++bj) {
                    const int row = rowb + ai * 128 + m * 16; const size_t off = (size_t)row * 1024 + c8 + bj * 128;
                    float gv[8], v[8]; ldbf8(gate + off, gv); acc8(acc, ai, bj, m, v);
                    u32x4* slot = pt + ((ai * 4 + m) * 2 + bj) * 512;
                    if (u.sel == 0) {
#pragma unroll
                        for (int j = 0; j < 8; ++j) v[j] *= gv[j];
                        u32x4 w; w.x = cvt_pk_bf16(v[0], v[1]); w.y = cvt_pk_bf16(v[2], v[3]); w.z = cvt_pk_bf16(v[4], v[5]); w.w = cvt_pk_bf16(v[6], v[7]); *slot = w;
                    } else {
                        float pv[8]; ldbf8((const bf16_t*)slot, pv);
#pragma unroll
                        for (int j = 0; j < 8; ++j) v[j] = pv[j] + v[j] * gv[j];
                        st8(mg + off, v);
                    }
                }
    }
};

struct Epi3 {
    Ptrs P;
    __device__ __forceinline__ void operator()(const acc_t& acc, const pg8::Unit& u, int wr, int wc, int fr, int fq) const {
        unsigned char* ws = P.ws; const int rowb = u.pm * 256 + wr * 64 + fr, c8 = u.pn * 256 + wc * 32 + fq * 8;
        bf16_t* x1b = (bf16_t*)(ws + WS_X1B); float* rs = (float*)(ws + WS_RS);
#pragma unroll
        for (int ai = 0; ai < 2; ++ai)
#pragma unroll
            for (int m = 0; m < 4; ++m) {
                const int row = rowb + ai * 128 + m * 16; float ss = 0.f;
#pragma unroll
                for (int bj = 0; bj < 2; ++bj) {
                    const size_t off = (size_t)row * 1024 + c8 + bj * 128; float xv[8], v[8]; ld8(P.x + off, xv); acc8(acc, ai, bj, m, v);
#pragma unroll
                    for (int j = 0; j < 8; ++j) { v[j] += xv[j]; ss += v[j] * v[j]; }
                    *(f32x4*)(P.out + off) = (f32x4){v[0], v[1], v[2], v[3]}; *(f32x4*)(P.out + off + 4) = (f32x4){v[4], v[5], v[6], v[7]};
                    st8(x1b + off, v);
                }
                ss += __shfl_xor(ss, 16); ss += __shfl_xor(ss, 32);
                if (fq == 0) rs[(size_t)row * 16 + u.pn * 4 + wc] = ss;
            }
    }
};

struct Epi4 {
    Ptrs P;
    __device__ __forceinline__ void operator()(const acc_t& acc, const pg8::Unit& u, int wr, int wc, int fr, int fq) const {
        unsigned char* ws = P.ws; const int rowb = u.pm * 256 + wr * 64 + fr, c8 = u.pn * 128 + wc * 32 + fq * 8;
        bf16_t* actp = (bf16_t*)(ws + WS_ACT); const float* rs = (const float*)(ws + WS_RS);
#pragma unroll
        for (int ai = 0; ai < 2; ++ai)
#pragma unroll
            for (int m = 0; m < 4; ++m) {
                const int row = rowb + ai * 128 + m * 16;
                const f32x4 r0 = *(const f32x4*)(rs + (size_t)row * 16), r1 = *(const f32x4*)(rs + (size_t)row * 16 + 4), r2 = *(const f32x4*)(rs + (size_t)row * 16 + 8), r3 = *(const f32x4*)(rs + (size_t)row * 16 + 12);
                const float ssum = ((r0[0] + r0[1]) + (r0[2] + r0[3])) + ((r1[0] + r1[1]) + (r1[2] + r1[3])) + ((r2[0] + r2[1]) + (r2[2] + r2[3])) + ((r3[0] + r3[1]) + (r3[2] + r3[3]));
                const float rn = 1.0f / sqrtf(ssum * (1.0f / 1024.0f) + EPS);
                float gv[8], uv[8], o[8]; acc8(acc, ai, 0, m, gv); acc8(acc, ai, 1, m, uv);
#pragma unroll
                for (int j = 0; j < 8; ++j) { const float gg = gv[j] * rn, uu = uv[j] * rn; o[j] = gg * sigmoidf_(gg) * uu; }
                st8(actp + (size_t)row * DFF + c8, o);
            }
    }
};

struct Epi5 {
    Ptrs P;
    __device__ __forceinline__ void operator()(const acc_t& acc, const pg8::Unit& u, int wr, int wc, int fr, int fq) const {
        const int rowb = u.pm * 256 + wr * 64 + fr, c8 = u.pn * 256 + wc * 32 + fq * 8;
#pragma unroll
        for (int ai = 0; ai < 2; ++ai)
#pragma unroll
            for (int m = 0; m < 4; ++m)
#pragma unroll
                for (int bj = 0; bj < 2; ++bj) {
                    const size_t off = (size_t)(rowb + ai * 128 + m * 16) * 1024 + c8 + bj * 128; float xv[8], v[8]; ld8(P.out + off, xv); acc8(acc, ai, bj, m, v);
                    *(f32x4*)(P.out + off) = (f32x4){v[0] + xv[0], v[1] + xv[1], v[2] + xv[2], v[3] + xv[3]}; *(f32x4*)(P.out + off + 4) = (f32x4){v[4] + xv[4], v[5] + xv[5], v[6] + xv[6], v[7] + xv[7]};
                }
    }
};

constexpr int NWAVES = 8;
constexpr int RING_OFF = 0, RING_BYTES = 131072;
constexpr int SCR_BYTES = 139264;
constexpr int LDSCTL_OFF = SCR_BYTES, MISC_OFF = LDSCTL_OFF + 320;
constexpr int LDS_BYTES = 147456;
#define RLX_AGENT __ATOMIC_RELAXED, __HIP_MEMORY_SCOPE_AGENT
#define LDS_WAIT() asm volatile("s_waitcnt lgkmcnt(0)" ::: "memory")
#define VM_WAIT() asm volatile("s_waitcnt vmcnt(0)" ::: "memory")

#define XB_TMO      128
#define XB_XCNT(j)  (256  + 64 * (j))
#define XB_XSUB(j)  (1280 + 64 * (j))
#define XB_XGEN(j)  (2304 + 64 * (j))
#define XB_TOP      3328
#define XB_TOPGEN   3392
#define XCD_BAR_WORDS 3456
#define XB_SPIN_CAP (1u << 22)
__device__ __forceinline__ unsigned xb_ld(unsigned* p)              { return __hip_atomic_load(p, __ATOMIC_RELAXED, __HIP_MEMORY_SCOPE_AGENT); }
__device__ __forceinline__ unsigned xb_add(unsigned* p, unsigned v) { return __hip_atomic_fetch_add(p, v, __ATOMIC_RELAXED, __HIP_MEMORY_SCOPE_AGENT); }
__device__ __forceinline__ unsigned xb_xcc_id() { return (unsigned)__builtin_amdgcn_s_getreg((3 << 11) | 20) & 0xFu; }
#define XB_SPIN(cond, bar) do { unsigned _sp = 0; while (cond) { __builtin_amdgcn_s_sleep(1); \
    if ((++_sp & 255u) == 0u) { if (xb_ld(&(bar)[XB_TMO])) break; if (_sp > XB_SPIN_CAP) { atomicAdd(&(bar)[XB_TMO], 1u); break; } } } } while (0)
struct XcdBarrier { unsigned* bar; unsigned x; volatile LAS unsigned* st; };
__device__ __forceinline__ XcdBarrier xcd_barrier_post(unsigned* bar, volatile LAS unsigned* st) {
    XcdBarrier b; b.bar = bar; b.x = xb_xcc_id(); b.st = st;
    if (threadIdx.x == 0) (void)xb_add(&bar[XB_XCNT(b.x)], 1u);
    return b;
}
__device__ __forceinline__ void xcd_barrier_complete(unsigned* bar, unsigned x, unsigned& nloc, unsigned& nx) {
    const unsigned G = gridDim.x * gridDim.y * gridDim.z;
    unsigned sum, cnt, mine, sp = 0u;
    for (;;) {
        sum = 0u; cnt = 0u; mine = 0u;
#pragma unroll
        for (unsigned j = 0; j < 16; ++j) { const unsigned c = xb_ld(&bar[XB_XCNT(j)]); sum += c; cnt += (c > 0u) ? 1u : 0u; mine = (j == x) ? c : mine; }
        if (sum == G) break;
        __builtin_amdgcn_s_sleep(1);
        if ((++sp & 255u) == 0u) { if (xb_ld(&bar[XB_TMO])) break; if (sp > XB_SPIN_CAP) { atomicAdd(&bar[XB_TMO], 1u); break; } }
    }
    nloc = mine > 0u ? mine : 1u; nx = cnt > 0u ? cnt : 1u;
}
__device__ __forceinline__ void xcd_barrier(const XcdBarrier& b) {
    asm volatile("s_waitcnt vmcnt(0)" ::: "memory");
    __syncthreads();
    if (threadIdx.x == 0) {
        unsigned* bar = b.bar;
        __builtin_amdgcn_s_waitcnt(0);
        unsigned nloc = b.st[0], nx = b.st[1];
        if (nloc == 0u) { xcd_barrier_complete(bar, b.x, nloc, nx); b.st[0] = nloc; b.st[1] = nx; }
        const unsigned old = xb_add(&bar[XB_XSUB(b.x)], 1u);
        const unsigned gen = old / nloc;
        if (old + 1u == (gen + 1u) * nloc) {
            __builtin_amdgcn_fence(__ATOMIC_RELEASE, "agent");
            asm volatile("s_waitcnt vmcnt(0)" ::: "memory");
            const unsigned og = xb_add(&bar[XB_TOP], 1u);
            const unsigned tg = og / nx;
            if (og + 1u == (tg + 1u) * nx) xb_add(&bar[XB_TOPGEN], 1u);
            else XB_SPIN(xb_ld(&bar[XB_TOPGEN]) == tg, bar);
            __builtin_amdgcn_fence(__ATOMIC_ACQUIRE, "agent");
            xb_add(&bar[XB_XGEN(b.x)], 1u);
            asm volatile("s_waitcnt vmcnt(0)" ::: "memory");
        } else {
            XB_SPIN(xb_ld(&bar[XB_XGEN(b.x)]) == gen, bar);
            __builtin_amdgcn_fence(__ATOMIC_ACQUIRE, "agent");
            asm volatile("s_waitcnt vmcnt(0)" ::: "memory");
        }
    }
    __syncthreads();
}

__device__ __forceinline__ int slot_col(int gm, int srow, int& which) {
    const int pn = srow >> 8, s = srow & 255, bj = s >> 7, wc = (s >> 5) & 3, n = (s >> 4) & 1, fq = (s >> 2) & 3, j = s & 3;
    which = 0;
    if (gm == 0) {
        if (pn < 4) return pn * 256 + (wc >> 1) * 128 + bj * 64 + (wc & 1) * 32 + fq * 8 + n * 4 + j;
        if (pn >= 12 && pn < 16) return pn * 256 + wc * 64 + bj * 32 + fq * 8 + n * 4 + j;
        if (pn == 16 && bj == 0) return 4096 + (wc >> 1) * 64 + n * 32 + (wc & 1) * 16 + fq * 4 + j;
    }
    if (gm == 4) { which = bj; return pn * 128 + wc * 32 + fq * 8 + n * 4 + j; }
    return pn * 256 + bj * 128 + wc * 32 + fq * 8 + n * 4 + j;
}
__device__ __forceinline__ void p0_transpose_item(const float* W0, const float* W1, int K, int N, const float* kscale, bf16_t* WT, int gm, LAS float* scr, int item, int lane) {
    const int nblk_k = K / 64, sb = item / nblk_k, kb = item % nblk_k, k0 = 64 * kb, s0 = 32 * sb;
    int which; const int col = slot_col(gm, s0 + (lane & 31), which); const float* W = which ? W1 : W0;
#pragma unroll 8
    for (int i = 0; i < 32; ++i) { const int kk = 2 * i + (lane >> 5); float v = W[(size_t)(k0 + kk) * N + col]; if (kscale) v *= kscale[k0 + kk]; scr[kk * 33 + (lane & 31)] = v; }
    LDS_WAIT(); asm volatile("" ::: "memory");
    const int c = lane & 7;
#pragma unroll
    for (int j = 0; j < 4; ++j) { const int n = (lane >> 3) + 8 * j; const LAS float* s = scr + (8 * c) * 33 + n;
        u32x4 o; o.x = pk2(s[0 * 33], s[1 * 33]); o.y = pk2(s[2 * 33], s[3 * 33]); o.z = pk2(s[4 * 33], s[5 * 33]); o.w = pk2(s[6 * 33], s[7 * 33]);
        *(u32x4*)(WT + (size_t)(s0 + n) * K + k0 + 8 * c) = o; }
    LDS_WAIT(); asm volatile("" ::: "memory");
}
__device__ __forceinline__ void sincos_d(double a, float& s, float& c) {
    const double k = rint(a * 0.63661977236758134308);
    double r = fma(-k, 1.57079632679489655800e+00, a); r = fma(-k, 6.12323399573676603587e-17, r);
    const double r2 = r * r;
    double sp = 1.0 / 6227020800.0; sp = fma(sp, r2, -1.0 / 39916800.0); sp = fma(sp, r2, 1.0 / 362880.0); sp = fma(sp, r2, -1.0 / 5040.0); sp = fma(sp, r2, 1.0 / 120.0); sp = fma(sp, r2, -1.0 / 6.0); sp = fma(sp * r2, r, r);
    double cp = 1.0 / 87178291200.0; cp = fma(cp, r2, -1.0 / 479001600.0); cp = fma(cp, r2, 1.0 / 3628800.0); cp = fma(cp, r2, -1.0 / 40320.0); cp = fma(cp, r2, 1.0 / 720.0); cp = fma(cp, r2, -1.0 / 24.0); cp = fma(cp, r2, 0.5); cp = fma(-cp, r2, 1.0);
    const int q = ((int)k) & 3;
    const double ss = (q & 1) ? cp : sp, cc = (q & 1) ? sp : cp;
    s = (float)((q & 2) ? -ss : ss); c = (float)(((q + 1) & 2) ? -cc : cc);
}

struct Frame {
    LAS unsigned char* lds; volatile LAS unsigned* MISC; gu32* ctl;
    int tid, lane, wave, vcu, G;
};

__device__ __forceinline__ void p0_prologue(const Frame& F, const float* const* in, const Ptrs& P) {
    unsigned char* ws = P.ws;
    LAS float* scr = (LAS float*)(F.lds + RING_OFF + F.wave * 16384);
    const int gw = F.vcu * NWAVES + F.wave, NGW = F.G * NWAVES;
    constexpr int I0 = (DIN / 32) * (D / 64), I1 = (D / 32) * (D / 64), I4 = (NGU / 32) * (D / 64), I5 = (D / 32) * (DFF / 64);
    constexpr int NITEMS = I0 + 3 * I1 + I4 + I5;
    for (int it = gw; it < NITEMS; it += NGW) {
        int r = it;
        if (r < I0) { p0_transpose_item(in[2], nullptr, D, DIN, nullptr, (bf16_t*)(ws + WS_W1), 0, scr, r, F.lane); continue; } r -= I0;
        if (r < I1) { p0_transpose_item(in[5], nullptr, D, D, nullptr, (bf16_t*)(ws + WS_WR), 1, scr, r, F.lane); continue; } r -= I1;
        if (r < I1) { p0_transpose_item(in[7], nullptr, D, D, nullptr, (bf16_t*)(ws + WS_WA), 2, scr, r, F.lane); continue; } r -= I1;
        if (r < I1) { p0_transpose_item(in[8], nullptr, D, D, nullptr, (bf16_t*)(ws + WS_WO), 3, scr, r, F.lane); continue; } r -= I1;
        if (r < I4) { p0_transpose_item(in[10], in[11], D, DFF, in[9], (bf16_t*)(ws + WS_WGU), 4, scr, r, F.lane); continue; } r -= I4;
        p0_transpose_item(in[12], nullptr, DFF, D, nullptr, (bf16_t*)(ws + WS_WD), 5, scr, r, F.lane);
    }
    {
        float* cosR = (float*)(ws + WS_COSR); float* sinR = (float*)(ws + WS_SINR); float* cosA = (float*)(ws + WS_COSA); float* sinA = (float*)(ws + WS_SINA);
        const int gt = F.vcu * (NWAVES * 64) + F.tid, NGT = F.G * NWAVES * 64;
        for (int e = gt; e < SEQ * 64; e += NGT) {
            const int pos = e >> 6, i = e & 63;
            double inv = 1.0; for (int k = 0; k < i; ++k) inv *= 0.8659643233600653;
            float s, c; sincos_d((double)pos * inv, s, c);
            cosR[e] = c; sinR[e] = s;
            if ((i & 1) == 0) { cosA[pos * 32 + (i >> 1)] = c; sinA[pos * 32 + (i >> 1)] = s; }
        }
    }
    {
        const float* g1 = in[1]; bf16_t* H1 = (bf16_t*)P.out;
        f32x4 gv[4];
#pragma unroll
        for (int j = 0; j < 4; ++j) gv[j] = *((const f32x4*)g1 + F.lane + 64 * j);
        for (int m = gw; m < M; m += NGW) {
            const f32x4* xr = (const f32x4*)(P.x + (size_t)m * D) + F.lane;
            f32x4 v[4]; float s = 0.f;
#pragma unroll
            for (int j = 0; j < 4; ++j) { v[j] = xr[64 * j]; s += (v[j].x * v[j].x + v[j].y * v[j].y) + (v[j].z * v[j].z + v[j].w * v[j].w); }
            const float rn = 1.0f / sqrtf(wave_sum(s) * (1.0f / D) + EPS);
            unsigned long long* o8 = (unsigned long long*)(H1 + (size_t)m * D) + F.lane;
#pragma unroll
            for (int j = 0; j < 4; ++j) { const f32x4 y = v[j] * rn * gv[j]; o8[64 * j] = (unsigned long long)cvt_pk_bf16(y.x, y.y) | ((unsigned long long)cvt_pk_bf16(y.z, y.w) << 32); }
        }
    }
}

__device__ __forceinline__ void p2_attention_simple(const Frame& F, const Ptrs& P) {
    unsigned char* ws = P.ws;
    bf16_t* AQ = (bf16_t*)(ws + WS_AQ); const bf16_t* AK = (const bf16_t*)(ws + WS_AK); const bf16_t* AV = (const bf16_t*)(ws + WS_AV);
    const int gw = F.vcu * NWAVES + F.wave, NGW = F.G * NWAVES, lane = F.lane;
    for (int task = gw; task < M * AH; task += NGW) {
        const int row = task >> 4, hd = task & 15, kvh = hd >> 3, t = row & (SEQ - 1);
        float q[64];
        { const u32x4* qp = (const u32x4*)(AQ + (size_t)row * 1024 + hd * 64);
#pragma unroll
          for (int i = 0; i < 8; ++i) { const u32x4 w = qp[i]; q[8 * i] = bf_lo(w.x); q[8 * i + 1] = bf_hi(w.x); q[8 * i + 2] = bf_lo(w.y); q[8 * i + 3] = bf_hi(w.y); q[8 * i + 4] = bf_lo(w.z); q[8 * i + 5] = bf_hi(w.z); q[8 * i + 6] = bf_lo(w.w); q[8 * i + 7] = bf_hi(w.w); } }
        float sc[2];
#pragma unroll
        for (int h = 0; h < 2; ++h) {
            const int kk = lane + 64 * h; float s = -1e30f;
            if (kk <= t) {
                const u32x4* kp = (const u32x4*)(AK + (size_t)(row - kk) * 128 + kvh * 64); s = 0.f;
#pragma unroll
                for (int i = 0; i < 8; ++i) { const u32x4 w = kp[i]; s += q[8 * i] * bf_lo(w.x) + q[8 * i + 1] * bf_hi(w.x) + q[8 * i + 2] * bf_lo(w.y) + q[8 * i + 3] * bf_hi(w.y) + q[8 * i + 4] * bf_lo(w.z) + q[8 * i + 5] * bf_hi(w.z) + q[8 * i + 6] * bf_lo(w.w) + q[8 * i + 7] * bf_hi(w.w); }
            }
            sc[h] = s;
        }
        const float sink = P.sinks[hd];
        const float mx = fmaxf(wave_max(fmaxf(sc[0], sc[1])), sink);
        const float e0 = __expf(sc[0] - mx), e1 = __expf(sc[1] - mx);
        const float den = wave_sum(e0 + e1) + __expf(sink - mx);
        float o = 0.f;
        const int nk = t + 1 < 128 ? t + 1 : 128;
        for (int kk = 0; kk < nk; ++kk) {
            const float p = __shfl(kk < 64 ? e0 : e1, kk & 63);
            o += p * bf2f(AV[(size_t)(row - kk) * 128 + kvh * 64 + lane]);
        }
        o /= den;
        AQ[(size_t)row * 1024 + hd * 64 + lane] = (bf16_t)f2bf(o);
    }
}

__device__ __forceinline__ float ret_log2_gamma(int h) { return log2f(1.0f - exp2f(-5.0f - (float)h)); }

__device__ __forceinline__ void p2_retkv_simple(const Frame& F, const Ptrs& P) {
    unsigned char* ws = P.ws;
    const bf16_t* RK = (const bf16_t*)(ws + WS_RK); const bf16_t* RV = (const bf16_t*)(ws + WS_RV); bf16_t* KV = (bf16_t*)P.out;
    LAS float* Kl = (LAS float*)(F.lds + RING_OFF);
    const int tid = F.tid;
    for (int task = blockIdx.x; task < NB * RH * NCH; task += F.G) {
        const int n = task & (NCH - 1), h = (task >> 6) & 3, b = task >> 8; const int r0 = b * SEQ + n * RC;
        const float lg = ret_log2_gamma(h);
        __syncthreads();
        for (int i = tid; i < 128 * 128; i += 512) { const int s = i >> 7, d = i & 127; Kl[i] = bf2f(RK[(size_t)(r0 + s) * 512 + h * 128 + d]) * exp2f(lg * (float)(127 - s)); }
        __syncthreads();
        const int e = tid & 255, dh = tid >> 8;
        float acc[64];
#pragma unroll
        for (int i = 0; i < 64; ++i) acc[i] = 0.f;
        for (int s = 0; s < 128; ++s) {
            const float v = bf2f(RV[(size_t)(r0 + s) * 1024 + h * 256 + e]);
            const LAS f32x4* kr = (const LAS f32x4*)(Kl + s * 128 + dh * 64);
#pragma unroll
            for (int i = 0; i < 16; ++i) { const f32x4 k4 = kr[i]; acc[4 * i] += k4[0] * v; acc[4 * i + 1] += k4[1] * v; acc[4 * i + 2] += k4[2] * v; acc[4 * i + 3] += k4[3] * v; }
        }
        bf16_t* op = KV + ((size_t)task * 256 + e) * 128 + dh * 64;
#pragma unroll
        for (int i = 0; i < 8; ++i) { u32x4 w; w.x = cvt_pk_bf16(acc[8 * i], acc[8 * i + 1]); w.y = cvt_pk_bf16(acc[8 * i + 2], acc[8 * i + 3]); w.z = cvt_pk_bf16(acc[8 * i + 4], acc[8 * i + 5]); w.w = cvt_pk_bf16(acc[8 * i + 6], acc[8 * i + 7]); *(u32x4*)(op + 8 * i) = w; }
    }
}

__device__ __forceinline__ void p3_scan(const Frame& F, const Ptrs& P) {
    const bf16_t* KV = (const bf16_t*)P.out; bf16_t* S = (bf16_t*)((unsigned char*)P.out + 64 * MiB);
    const int gt = F.vcu * (NWAVES * 64) + F.tid, NGT = F.G * NWAVES * 64;
    for (int it = gt; it < NB * RH * (RDV * RDK / 8); it += NGT) {
        const int bh = it >> 12, el = (it & 4095) * 8; const int h = bh & 3;
        const float cd = exp2f(ret_log2_gamma(h) * 128.0f);
        float st[8];
#pragma unroll
        for (int j = 0; j < 8; ++j) st[j] = 0.f;
        const size_t base = (size_t)bh * NCH * 32768 + el;
#pragma unroll 4
        for (int n = 0; n < NCH; ++n) {
            float kv[8]; ldbf8(KV + base + (size_t)n * 32768, kv);
            st8(S + base + (size_t)n * 32768, st);
#pragma unroll
            for (int j = 0; j < 8; ++j) st[j] = st[j] * cd + kv[j];
        }
    }
}

__device__ __forceinline__ void p4_retout_simple(const Frame& F, const Ptrs& P) {
    unsigned char* ws = P.ws;
    const bf16_t* RQ = (const bf16_t*)(ws + WS_RQ); const bf16_t* RK = (const bf16_t*)(ws + WS_RK); const bf16_t* RV = (const bf16_t*)(ws + WS_RV); bf16_t* RG = (bf16_t*)(ws + WS_RG);
    const bf16_t* S = (const bf16_t*)((unsigned char*)P.out + 64 * MiB);
    LAS unsigned* Ql = (LAS unsigned*)(F.lds + RING_OFF);
    LAS unsigned* Kl = (LAS unsigned*)(F.lds + RING_OFF + 32768);
    LAS float* Pl = (LAS float*)(F.lds + RING_OFF + 66048);
    const int tid = F.tid, lane = F.lane, wave = F.wave;
    for (int task = blockIdx.x; task < NB * RH * NCH; task += F.G) {
        const int n = task & (NCH - 1), h = (task >> 6) & 3, b = task >> 8; const int r0 = b * SEQ + n * RC;
        const float lg = ret_log2_gamma(h);
        __syncthreads();
        for (int i = tid; i < 128 * 64; i += 512) { const int s = i >> 6, d2 = i & 63;
            Ql[s * 64 + d2] = *(const unsigned*)(RQ + (size_t)(r0 + s) * 512 + h * 128 + 2 * d2);
            Kl[s * 65 + d2] = *(const unsigned*)(RK + (size_t)(r0 + s) * 512 + h * 128 + 2 * d2); }
        __syncthreads();
        {
            const int s = tid & 127, cq = tid >> 7; float a[32];
#pragma unroll
            for (int i = 0; i < 32; ++i) a[i] = 0.f;
            for (int d2 = 0; d2 < 64; ++d2) {
                const unsigned kw = Kl[s * 65 + d2]; const float k0 = bf_lo(kw), k1 = bf_hi(kw);
#pragma unroll
                for (int i = 0; i < 32; ++i) { const unsigned qw = Ql[(cq * 32 + i) * 64 + d2]; a[i] += bf_lo(qw) * k0 + bf_hi(qw) * k1; }
            }
#pragma unroll
            for (int i = 0; i < 32; ++i) { const int c = cq * 32 + i; Pl[c * 128 + s] = c >= s ? a[i] * exp2f(lg * (float)(c - s)) : 0.f; }
        }
        __syncthreads();
        const int e = tid & 255, ch = tid >> 8;
        LAS float* red = (LAS float*)(F.lds + RING_OFF + 131584);
        const float gg = P.rg_g[h * 256 + e];
#pragma unroll 1
        for (int pass = 0; pass < 2; ++pass) {
            const int cb = pass * 64 + ch * 32;
            float acc[32], acc2[32];
#pragma unroll
            for (int i = 0; i < 32; ++i) { acc[i] = 0.f; acc2[i] = 0.f; }
            for (int s = 0; s < 128; ++s) {
                const float v = bf2f(RV[(size_t)(r0 + s) * 1024 + h * 256 + e]);
#pragma unroll
                for (int i = 0; i < 32; ++i) acc[i] += Pl[(cb + i) * 128 + s] * v;
            }
            const bf16_t* sp = S + ((size_t)task * 256 + e) * 128;
            for (int d2 = 0; d2 < 64; ++d2) {
                const unsigned sw = *(const unsigned*)(sp + 2 * d2); const float s0 = bf_lo(sw), s1 = bf_hi(sw);
#pragma unroll
                for (int i = 0; i < 32; ++i) { const unsigned qw = Ql[(cb + i) * 64 + d2]; acc2[i] += bf_lo(qw) * s0 + bf_hi(qw) * s1; }
            }
#pragma unroll
            for (int i = 0; i < 32; ++i) {
                acc[i] += exp2f(lg * (float)(cb + i + 1)) * acc2[i];
                const float s1 = wave_sum(acc[i]), s2 = wave_sum(acc[i] * acc[i]);
                if (lane == 0) { red[((cb + i) * 4 + (wave & 3)) * 2] = s1; red[((cb + i) * 4 + (wave & 3)) * 2 + 1] = s2; }
            }
            __syncthreads();
#pragma unroll
            for (int i = 0; i < 32; ++i) {
                const LAS f32x4* rp = (const LAS f32x4*)(red + (cb + i) * 8); const f32x4 ra = rp[0], rb = rp[1];
                const float mean = ((ra[0] + ra[2]) + (rb[0] + rb[2])) * (1.0f / 256.0f), ex2 = ((ra[1] + ra[3]) + (rb[1] + rb[3])) * (1.0f / 256.0f);
                const float rstd = 1.0f / sqrtf(fmaxf(ex2 - mean * mean, 0.f) + EPS);
                bf16_t* gp = RG + (size_t)(r0 + cb + i) * 1024 + h * 256 + e;
                *gp = (bf16_t)f2bf((acc[i] - mean) * rstd * gg * bf2f(*gp));
            }
        }
    }
}

__device__ __forceinline__ void p9_final_norm(const Frame& F, const Ptrs& P) {
    const int gw = F.vcu * NWAVES + F.wave, NGW = F.G * NWAVES;
    f32x4 gv[4];
#pragma unroll
    for (int j = 0; j < 4; ++j) gv[j] = *((const f32x4*)P.lnf_g + F.lane + 64 * j);
    for (int m = gw; m < M; m += NGW) {
        f32x4* xr = (f32x4*)(P.out + (size_t)m * D) + F.lane;
        f32x4 v[4]; float s = 0.f;
#pragma unroll
        for (int j = 0; j < 4; ++j) { v[j] = xr[64 * j]; s += (v[j].x * v[j].x + v[j].y * v[j].y) + (v[j].z * v[j].z + v[j].w * v[j].w); }
        const float rn = 1.0f / sqrtf(wave_sum(s) * (1.0f / D) + EPS);
#pragma unroll
        for (int j = 0; j < 4; ++j) xr[64 * j] = v[j] * rn * gv[j];
    }
}

constexpr int PER_PHASE = 10;
constexpr int N_LAUNCHES = MK_N_LAUNCHES;
struct Args { const float* in[14]; float* out; unsigned char* ws; int ph_lo, ph_hi, li, pad; };

__global__ void __launch_bounds__(NWAVES * 64, 2) fwd_kernel(Args args) {
    extern __shared__ __attribute__((aligned(16))) unsigned char lds[];
    Frame F;
    F.lds = (LAS unsigned char*)lds;
    F.MISC = (volatile LAS unsigned*)(F.lds + MISC_OFF);
    F.tid = threadIdx.x; F.lane = F.tid & 63; F.wave = __builtin_amdgcn_readfirstlane(F.tid >> 6);
    F.G = gridDim.x; { const int bx = blockIdx.x; F.vcu = (F.G % 8 == 0) ? (bx % 8) * (F.G / 8) + bx / 8 : bx; }
    unsigned char* ws = args.ws;
    F.ctl = (gu32*)(ws + WS_CTL);
    Ptrs P; P.x = args.in[0]; P.b_in = args.in[3]; P.rg_g = args.in[4]; P.sinks = args.in[6]; P.lnf_g = args.in[13]; P.out = args.out; P.ws = ws;
    for (int u = F.tid; u < (LDS_BYTES - LDSCTL_OFF) / 4; u += NWAVES * 64) ((LAS unsigned*)(F.lds + LDSCTL_OFF))[u] = 0u;
    __syncthreads();
    XcdBarrier bar; bar.bar = (unsigned*)(F.ctl + CW_BAR); bar.x = 0; bar.st = nullptr;
    if (N_LAUNCHES == 1) bar = xcd_barrier_post((unsigned*)(F.ctl + CW_BAR), F.MISC + 8);
#define GRID_BAR() do { if (N_LAUNCHES == 1) xcd_barrier(bar); } while (0)
    const int lo = args.ph_lo, hi = args.ph_hi;
#define IN(k) (lo <= (k) && (k) < hi)
#define BOTH(k) (IN(k) && IN((k) + 1))
    using namespace pg8;
    if (IN(0)) { p0_prologue(F, args.in, P); if (BOTH(0)) GRID_BAR(); }
    if (IN(1)) {
        Gemm g{(const bf16_t*)P.out, (const bf16_t*)(ws + WS_W1), nullptr, nullptr, D}; StaticOrder S; S.init(M, DIN, F.G, (int)blockIdx.x);
        Epi1 E{P}; gemm_phase<Epi1, StaticOrder, true, true>(F.lds + RING_OFF, g, S, E);
        if (BOTH(1)) GRID_BAR();
    }
    if (IN(2)) { p2_attention_simple(F, P); p2_retkv_simple(F, P); if (BOTH(2)) GRID_BAR(); }
    if (IN(3)) { p3_scan(F, P); if (BOTH(3)) GRID_BAR(); }
    if (IN(4)) { p4_retout_simple(F, P); if (BOTH(4)) GRID_BAR(); }
    if (IN(5)) {
        Gemm g{(const bf16_t*)(ws + WS_RG), (const bf16_t*)(ws + WS_WR), (const bf16_t*)(ws + WS_AQ), (const bf16_t*)(ws + WS_WA), D}; DualOrder S; S.init(M, D, F.G, (int)blockIdx.x);
        Epi2 E{P}; gemm_phase<Epi2, DualOrder, true, true>(F.lds + RING_OFF, g, S, E);
        if (BOTH(5)) GRID_BAR();
    }
    if (IN(6)) {
        Gemm g{(const bf16_t*)(ws + WS_MG), (const bf16_t*)(ws + WS_WO), nullptr, nullptr, D}; StaticOrder S; S.init(M, D, F.G, (int)blockIdx.x);
        Epi3 E{P}; gemm_phase<Epi3, StaticOrder, true, true>(F.lds + RING_OFF, g, S, E);
        if (BOTH(6)) GRID_BAR();
    }
    if (IN(7)) {
        Gemm g{(const bf16_t*)(ws + WS_X1B), (const bf16_t*)(ws + WS_WGU), nullptr, nullptr, D}; StaticOrder S; S.init(M, NGU, F.G, (int)blockIdx.x);
        Epi4 E{P}; gemm_phase<Epi4, StaticOrder, true, true>(F.lds + RING_OFF, g, S, E);
        if (BOTH(7)) GRID_BAR();
    }
    if (IN(8)) {
        Gemm g{(const bf16_t*)(ws + WS_ACT), (const bf16_t*)(ws + WS_WD), nullptr, nullptr, DFF}; StaticOrder S; S.init(M, D, F.G, (int)blockIdx.x);
        Epi5 E{P}; gemm_phase<Epi5, StaticOrder, true, true>(F.lds + RING_OFF, g, S, E);
        if (BOTH(8)) GRID_BAR();
    }
    if (IN(9)) { p9_final_norm(F, P); }
#undef IN
#undef BOTH
}

extern "C" void kernel_launch(void* const* d_in, const int* in_sizes, int n_in, void* d_out, int out_size, void* d_ws, size_t ws_size, hipStream_t stream) {
    static int grid = 0;
    if (grid == 0) {
        if (n_in != 14 || in_sizes[0] != M * D || out_size != M * D || ws_size < WS_END) { fprintf(stderr, "kernel_launch: unexpected shapes (n_in %d, in0 %d, out %d, ws %zu); nothing launched\n", n_in, n_in > 0 ? in_sizes[0] : -1, out_size, ws_size); grid = -1; return; }
        int dev = 0, cus = 0, per_cu = 0;
        if (hipGetDevice(&dev) != hipSuccess || hipDeviceGetAttribute(&cus, hipDeviceAttributeMultiprocessorCount, dev) != hipSuccess) { grid = -1; return; }
        if (hipFuncSetAttribute((const void*)fwd_kernel, hipFuncAttributeMaxDynamicSharedMemorySize, LDS_BYTES) != hipSuccess) { fprintf(stderr, "kernel_launch: hipFuncSetAttribute failed\n"); grid = -1; return; }
        if (hipOccupancyMaxActiveBlocksPerMultiprocessor(&per_cu, (const void*)fwd_kernel, NWAVES * 64, LDS_BYTES) != hipSuccess || per_cu < 1) { fprintf(stderr, "kernel_launch: occupancy query says %d blocks per CU\n", per_cu); }
        (void)hipGetLastError();
        grid = cus;
    }
    if (grid < 0) return;
    (void)hipMemsetAsync((char*)d_ws + WS_CTL, 0, CTL_ZERO_BYTES, stream);
    Args a{};
    for (int i = 0; i < 14; ++i) a.in[i] = (const float*)d_in[i];
    a.out = (float*)d_out; a.ws = (unsigned char*)d_ws;
    for (int li = 0; li < N_LAUNCHES; ++li) {
        a.ph_lo = (N_LAUNCHES == 1) ? 0 : li; a.ph_hi = (N_LAUNCHES == 1) ? PER_PHASE : li + 1; a.li = li;
        hipLaunchKernelGGL(fwd_kernel, dim3(grid), dim3(NWAVES * 64), LDS_BYTES, stream, a);
    }
}
```

```cpp
#include <hip/hip_runtime.h>
#include <cstdio>
#include <cstdint>

#ifndef MK_N_LAUNCHES
#define MK_N_LAUNCHES 1
#endif

constexpr int NB = 4, SEQ = 8192, D = 1024, M = NB * SEQ;
constexpr int DIN = 6400, DFF = 2816, NGU = 2 * DFF;
constexpr int RH = 4, RDK = 128, RDV = 256, RC = 128, NCH = SEQ / RC;
constexpr int AH = 16, AKV = 2, AD = 64, AWIN = 128;
constexpr float EPS = 1e-6f;

#define LAS __attribute__((address_space(3)))
#define GAS __attribute__((address_space(1)))
typedef unsigned short bf16_t;
typedef short bf16x8 __attribute__((ext_vector_type(8)));
typedef float f32x4 __attribute__((ext_vector_type(4)));
typedef float f32x2 __attribute__((ext_vector_type(2)));
typedef unsigned u32x4 __attribute__((ext_vector_type(4)));
typedef unsigned u32x2 __attribute__((ext_vector_type(2)));
typedef GAS unsigned gu32;

__device__ __forceinline__ unsigned cvt_pk_bf16(float lo, float hi) { unsigned r; asm volatile("v_cvt_pk_bf16_f32 %0, %1, %2" : "=v"(r) : "v"(lo), "v"(hi)); return r; }
__device__ __forceinline__ float bf_lo(unsigned w) { return __uint_as_float(w << 16); }
__device__ __forceinline__ float bf_hi(unsigned w) { return __uint_as_float(w & 0xffff0000u); }
__device__ __forceinline__ float bf2f(bf16_t v) { return __uint_as_float((unsigned)v << 16); }
__device__ __forceinline__ unsigned f2bf(float f) { unsigned u = __builtin_bit_cast(unsigned, f); return (u + 0x7fffu + ((u >> 16) & 1u)) >> 16; }
__device__ __forceinline__ unsigned pk2(float lo, float hi) { return f2bf(lo) | (f2bf(hi) << 16); }
__device__ __forceinline__ float sigmoidf_(float v) { return 1.0f / (1.0f + __expf(-v)); }
__device__ __forceinline__ float wave_sum(float v) {
#pragma unroll
    for (int o = 1; o < 64; o <<= 1) v += __shfl_xor(v, o);
    return v;
}
__device__ __forceinline__ float wave_max(float v) {
#pragma unroll
    for (int o = 1; o < 64; o <<= 1) v = fmaxf(v, __shfl_xor(v, o));
    return v;
}

__device__ __forceinline__ float ret_log2_gamma(int h) { return log2f(1.0f - exp2f(-5.0f - (float)h)); }

constexpr size_t MiB = 1u << 20;
constexpr size_t WS_CTL = 0, CTL_ZERO_BYTES = 64 * 1024;
constexpr size_t WS_W1 = 1 * MiB;
constexpr size_t WS_WR = 14 * MiB;
constexpr size_t WS_WA = 16 * MiB;
constexpr size_t WS_WO = 18 * MiB;
constexpr size_t WS_WGU = 20 * MiB;
constexpr size_t WS_WD = 31 * MiB;
constexpr size_t WS_COSR = 37 * MiB, WS_SINR = 39 * MiB, WS_COSA = 41 * MiB, WS_SINA = 42 * MiB;
constexpr size_t WS_RS = 43 * MiB;
constexpr size_t WS_RQ = 48 * MiB;
constexpr size_t WS_RK = 80 * MiB;
constexpr size_t WS_RV = 112 * MiB;
constexpr size_t WS_RG = 176 * MiB;
constexpr size_t WS_AQ = 240 * MiB;
constexpr size_t WS_AK = 304 * MiB;
constexpr size_t WS_AV = 312 * MiB;
constexpr size_t WS_GA = 320 * MiB;
constexpr size_t WS_GB = 384 * MiB;
constexpr size_t WS_END = 448 * MiB;
constexpr size_t WS_MG = WS_RQ;
constexpr size_t WS_X1B = WS_RV;
constexpr size_t WS_ACT = WS_RG;
static_assert(WS_ACT + (size_t)M * DFF * 2 <= WS_END, "act overlay");

constexpr int CW_TMO = 0, CW_CODE = 1, CW_BAR = 1024;

namespace pg8 {
#define PG8_LAS __attribute__((address_space(3)))
constexpr int BM = 256, BK = 64, HALF = 128, HTB = HALF * BK * 2, STAGE_BYTES = 8 * HTB, NXCD = 8, WGM = 8;
__host__ __device__ __forceinline__ int lds_byte(int r, int c) { const int st = (r >> 4) * 2 + (c >> 5), rr = r & 15, cc = c & 31, ob = rr * 64 + cc * 2; return st * 1024 + (ob ^ (((ob >> 9) & 1) << 5)); }
__host__ __device__ __forceinline__ void stage_rc(int b, int& R, int& C) { const int st = b / 1024, sb = b % 1024, swz = sb ^ (((sb >> 9) & 1) << 5); R = (st >> 1) * 16 + swz / 64; C = (st & 1) * 32 + (swz % 64) / 2; }

struct Unit { int pm, pn, sel; };
struct Gemm { const bf16_t* A0; const bf16_t* B0; const bf16_t* A1; const bf16_t* B1; int K; };

struct StaticOrder {
    int nM, nN, nwg, G, c;
    __device__ void init(int M_, int N_, int G_, int c_) { nM = M_ / BM; nN = N_ / BM; nwg = nM * nN; G = G_; c = c_; }
    __device__ bool tile(int i, Unit& u) const {
        const long L = (long)i * G + c; if (L >= nwg) return false;
        int wgid = (int)L; { const int q = nwg / NXCD, r = nwg % NXCD, xcd = wgid % NXCD, off = wgid / NXCD; wgid = (xcd < r ? xcd * (q + 1) : r * (q + 1) + (xcd - r) * q) + off; }
        const int nig = WGM * nN, gid = wgid / nig, fm = gid * WGM, gsz = (nM - fm) < WGM ? (nM - fm) : WGM;
        u.pm = fm + ((wgid % nig) % gsz); u.pn = (wgid % nig) / gsz; u.sel = 0; return true;
    }
    __device__ bool next(int i, Unit& u) const { return tile(i, u); }
};
struct DualOrder : StaticOrder {
    __device__ bool next(int i, Unit& u) const { if (!tile(i >> 1, u)) return false; u.sel = i & 1; return true; }
};

template <class Epi, class Sched, bool ALIGN_EPI, bool SP2>
__device__ __forceinline__ void gemm_phase(PG8_LAS unsigned char* lds, const Gemm g, const Sched& S, const Epi& E) {
    const int tid = threadIdx.x, wid = __builtin_amdgcn_readfirstlane(tid >> 6), lane = tid & 63, wr = wid >> 2, wc = wid & 3, fr = lane & 15, fq = lane >> 4;
    const int K = g.K, nt = K / BK;
    unsigned voffA[2];
#pragma unroll
    for (int i = 0; i < 2; ++i) { int R, C; stage_rc(tid * 16 + i * 8192, R, C); voffA[i] = (unsigned)(R * K + C) * 2u; }
    const size_t kstep = (size_t)(BK * 2);
    const size_t hstep = (size_t)HALF * K * 2;
    const size_t tstep = 2 * hstep;
    const unsigned ldsw = (unsigned)wid * 1024u;
    const int aoff = lds_byte(wr * 64 + fr, fq * 8), boff = lds_byte(wc * 32 + fr, fq * 8);
#define PG8_SA(b, h) (((b) * 2 + (h)) * HTB)
#define PG8_SB(b, h) ((4 + (b) * 2 + (h)) * HTB)
#define PG8_STAGE(bufoff, gbase) do { _Pragma("unroll") for (int _i = 0; _i < 2; ++_i) \
        __builtin_amdgcn_global_load_lds((const unsigned*)((const char*)(gbase) + voffA[_i]), (PG8_LAS unsigned*)(lds + (bufoff) + ldsw + _i * 8192), 16, 0, 0); } while (0)
#define PG8_LDA(dst, b, h) do { _Pragma("unroll") for (int m = 0; m < 4; ++m) _Pragma("unroll") for (int k = 0; k < 2; ++k) dst[m][k] = *(const PG8_LAS bf16x8*)(lds + PG8_SA(b, h) + aoff + m * 2048 + k * 1024); } while (0)
#define PG8_LDB(dst, b, h) do { _Pragma("unroll") for (int n = 0; n < 2; ++n) _Pragma("unroll") for (int k = 0; k < 2; ++k) dst[n][k] = *(const PG8_LAS bf16x8*)(lds + PG8_SB(b, h) + boff + n * 2048 + k * 1024); } while (0)
#define PG8_MMA(ai, bj, At, Bt) do { __builtin_amdgcn_s_setprio(1); _Pragma("unroll") for (int m = 0; m < 4; ++m) _Pragma("unroll") for (int n = 0; n < 2; ++n) _Pragma("unroll") for (int k = 0; k < 2; ++k) \
        acc[ai][bj][m][n] = __builtin_amdgcn_mfma_f32_16x16x32_bf16(Bt[n][k], At[m][k], acc[ai][bj][m][n], 0, 0, 0); __builtin_amdgcn_s_setprio(0); } while (0)
#define PG8_WAIT_V(n) asm volatile("s_waitcnt vmcnt(" #n ")" ::: "memory")
#define PG8_WAIT_L(n) asm volatile("s_waitcnt lgkmcnt(" #n ")" ::: "memory")
#define PG8_BAR __builtin_amdgcn_s_barrier()
#define PG8_SCHED __builtin_amdgcn_sched_barrier(0)
#define PG8_ABASE(u) ((const char*)((u).sel ? g.A1 : g.A0) + (size_t)(u).pm * tstep)
#define PG8_BBASE(u) ((const char*)((u).sel ? g.B1 : g.B0) + (size_t)(u).pn * tstep)
    Unit cur, nxt; int ui = 0;
    if (!S.next(0, cur)) return;
    f32x4 acc[2][2][4][2];
#pragma unroll
    for (int a = 0; a < 2; ++a)
#pragma unroll
        for (int b = 0; b < 2; ++b)
#pragma unroll
            for (int m = 0; m < 4; ++m)
#pragma unroll
                for (int n = 0; n < 2; ++n) acc[a][b][m][n] = (f32x4){0.f, 0.f, 0.f, 0.f};
    bf16x8 At[4][2], B0[2][2], B1[2][2];
    const char* cA = PG8_ABASE(cur); const char* cB = PG8_BBASE(cur);
    if constexpr (SP2) {
        PG8_STAGE(PG8_SB(0, 0), cB); PG8_STAGE(PG8_SB(0, 1), cB + hstep); PG8_STAGE(PG8_SA(0, 0), cA); PG8_STAGE(PG8_SA(0, 1), cA + hstep);
        if (wr == 1) PG8_BAR;
        PG8_WAIT_V(2); PG8_BAR;
        PG8_STAGE(PG8_SB(1, 0), cB + kstep); PG8_STAGE(PG8_SA(1, 0), cA + kstep); PG8_STAGE(PG8_SB(1, 1), cB + hstep + kstep);
        PG8_WAIT_V(6); PG8_BAR;
    } else {
        PG8_STAGE(PG8_SB(0, 0), cB); PG8_STAGE(PG8_SA(0, 0), cA); PG8_STAGE(PG8_SB(0, 1), cB + hstep); PG8_STAGE(PG8_SA(0, 1), cA + hstep);
        if (wr == 1) PG8_BAR;
        PG8_WAIT_V(4); PG8_BAR;
        PG8_STAGE(PG8_SB(1, 0), cB + kstep); PG8_STAGE(PG8_SA(1, 0), cA + kstep); PG8_STAGE(PG8_SB(1, 1), cB + hstep + kstep);
        PG8_WAIT_V(6); PG8_BAR;
    }
    for (;;) {
        const bool has_next = S.next(ui + 1, nxt);
        const char* nA = has_next ? PG8_ABASE(nxt) : cA; const char* nB = has_next ? PG8_BBASE(nxt) : cB;
        for (int t = 0; t < nt; t += 2) {
            const bool last = (t == nt - 2);
            const char* a1 = cA + (size_t)(t + 1) * kstep;
            const char* a2 = last ? nA : cA + (size_t)(t + 2) * kstep; const char* b2 = last ? nB : cB + (size_t)(t + 2) * kstep;
            const char* a3 = a2 + kstep; const char* b3 = b2 + kstep;
            if constexpr (SP2) {
            PG8_LDB(B0, 0, 0); PG8_LDB(B1, 0, 1); PG8_SCHED; PG8_LDA(At, 0, 0); PG8_STAGE(PG8_SA(1, 1), a1 + hstep);
            PG8_WAIT_V(8); PG8_WAIT_L(0); PG8_BAR; PG8_MMA(0, 0, At, B0); PG8_MMA(0, 1, At, B1); PG8_BAR; PG8_SCHED;
            PG8_LDA(At, 0, 1); PG8_STAGE(PG8_SB(0, 0), b2); PG8_STAGE(PG8_SB(0, 1), b2 + hstep); PG8_STAGE(PG8_SA(0, 0), a2);
            PG8_WAIT_V(8); PG8_WAIT_L(0); PG8_BAR; PG8_MMA(1, 0, At, B0); PG8_MMA(1, 1, At, B1); PG8_BAR; PG8_SCHED;
            PG8_LDB(B0, 1, 0); PG8_LDB(B1, 1, 1); PG8_SCHED; PG8_LDA(At, 1, 0); PG8_STAGE(PG8_SA(0, 1), a2 + hstep);
            PG8_WAIT_V(8); PG8_WAIT_L(0); PG8_BAR; PG8_MMA(0, 0, At, B0); PG8_MMA(0, 1, At, B1); PG8_BAR; PG8_SCHED;
            PG8_LDA(At, 1, 1); PG8_STAGE(PG8_SB(1, 0), b3); PG8_STAGE(PG8_SB(1, 1), b3 + hstep); PG8_STAGE(PG8_SA(1, 0), a3);
            PG8_WAIT_V(8); PG8_WAIT_L(0); PG8_BAR; PG8_MMA(1, 0, At, B0); PG8_MMA(1, 1, At, B1); PG8_BAR; PG8_SCHED;
            } else {
            PG8_LDB(B0, 0, 0); PG8_SCHED; PG8_LDA(At, 0, 0); PG8_STAGE(PG8_SA(1, 1), a1 + hstep);
            PG8_WAIT_L(8); PG8_BAR; PG8_WAIT_L(0); PG8_MMA(0, 0, At, B0); PG8_BAR; PG8_SCHED;
            PG8_LDB(B1, 0, 1); PG8_STAGE(PG8_SB(0, 0), b2);
            PG8_BAR; PG8_WAIT_L(0); PG8_MMA(0, 1, At, B1); PG8_BAR;
            PG8_LDA(At, 0, 1); PG8_STAGE(PG8_SA(0, 0), a2);
            PG8_BAR; PG8_WAIT_L(0); PG8_MMA(1, 0, At, B0); PG8_BAR; PG8_SCHED;
            PG8_STAGE(PG8_SB(0, 1), b2 + hstep);
            PG8_WAIT_V(6); PG8_BAR; PG8_MMA(1, 1, At, B1); PG8_BAR;
            PG8_LDB(B0, 1, 0); PG8_SCHED; PG8_LDA(At, 1, 0); PG8_STAGE(PG8_SA(0, 1), a2 + hstep);
            PG8_WAIT_L(8); PG8_BAR; PG8_WAIT_L(0); PG8_MMA(0, 0, At, B0); PG8_BAR; PG8_SCHED;
            PG8_LDB(B1, 1, 1); PG8_STAGE(PG8_SB(1, 0), b3);
            PG8_BAR; PG8_WAIT_L(0); PG8_MMA(0, 1, At, B1); PG8_BAR;
            PG8_LDA(At, 1, 1); PG8_STAGE(PG8_SA(1, 0), a3);
            PG8_BAR; PG8_WAIT_L(0); PG8_MMA(1, 0, At, B0); PG8_BAR; PG8_SCHED;
            PG8_STAGE(PG8_SB(1, 1), b3 + hstep);
            PG8_WAIT_V(6); PG8_BAR; PG8_MMA(1, 1, At, B1); PG8_BAR;
            }
        }
        if constexpr (ALIGN_EPI) { if (wr == 0) PG8_BAR; }
        E(acc, cur, wr, wc, fr, fq);
        if (!has_next) break;
#pragma unroll
        for (int a = 0; a < 2; ++a)
#pragma unroll
            for (int b = 0; b < 2; ++b)
#pragma unroll
                for (int m = 0; m < 4; ++m)
#pragma unroll
                    for (int n = 0; n < 2; ++n) acc[a][b][m][n] = (f32x4){0.f, 0.f, 0.f, 0.f};
        cur = nxt; cA = nA; cB = nB; ++ui;
        if constexpr (ALIGN_EPI) { if (wr == 1) PG8_BAR; }
    }
    PG8_WAIT_V(0);
    if constexpr (!ALIGN_EPI) { if (wr == 0) PG8_BAR; }
    PG8_BAR;
#undef PG8_SA
#undef PG8_SB
#undef PG8_STAGE
#undef PG8_LDA
#undef PG8_LDB
#undef PG8_MMA
#undef PG8_WAIT_V
#undef PG8_WAIT_L
#undef PG8_BAR
#undef PG8_SCHED
#undef PG8_ABASE
#undef PG8_BBASE
}
}

typedef f32x4 acc_t[2][2][4][2];

struct Ptrs {
    const float* x; const float* b_in; const float* rg_g; const float* sinks; const float* lnf_g;
    float* out; unsigned char* ws;
};
__device__ __forceinline__ void ld8(const float* p, float (&v)[8]) { const f32x4 a = *(const f32x4*)p, b = *(const f32x4*)(p + 4); v[0] = a[0]; v[1] = a[1]; v[2] = a[2]; v[3] = a[3]; v[4] = b[0]; v[5] = b[1]; v[6] = b[2]; v[7] = b[3]; }
__device__ __forceinline__ void ldbf8(const bf16_t* p, float (&v)[8]) { const u32x4 w = *(const u32x4*)p; v[0] = bf_lo(w.x); v[1] = bf_hi(w.x); v[2] = bf_lo(w.y); v[3] = bf_hi(w.y); v[4] = bf_lo(w.z); v[5] = bf_hi(w.z); v[6] = bf_lo(w.w); v[7] = bf_hi(w.w); }
__device__ __forceinline__ void ldbf8(const LAS bf16_t* p, float (&v)[8]) { const u32x4 w = *(const LAS u32x4*)p; v[0] = bf_lo(w.x); v[1] = bf_hi(w.x); v[2] = bf_lo(w.y); v[3] = bf_hi(w.y); v[4] = bf_lo(w.z); v[5] = bf_hi(w.z); v[6] = bf_lo(w.w); v[7] = bf_hi(w.w); }
__device__ __forceinline__ void st8(bf16_t* p, const float (&v)[8]) { u32x4 w; w.x = cvt_pk_bf16(v[0], v[1]); w.y = cvt_pk_bf16(v[2], v[3]); w.z = cvt_pk_bf16(v[4], v[5]); w.w = cvt_pk_bf16(v[6], v[7]); *(u32x4*)p = w; }
__device__ __forceinline__ void acc8(const acc_t& acc, int ai, int bj, int m, float (&v)[8]) { const f32x4 a = acc[ai][bj][m][0], b = acc[ai][bj][m][1]; v[0] = a[0]; v[1] = a[1]; v[2] = a[2]; v[3] = a[3]; v[4] = b[0]; v[5] = b[1]; v[6] = b[2]; v[7] = b[3]; }

struct Epi1 {
    Ptrs P;
    __device__ __forceinline__ void operator()(const acc_t& acc, const pg8::Unit& u, int wr, int wc, int fr, int fq) const {
        unsigned char* ws = P.ws; const int pn = u.pn; const int rowb = u.pm * 256 + wr * 64 + fr;
        const float* bias = P.b_in;
        if (pn < 4) {
            const int hd2 = wc >> 1, i0 = (wc & 1) * 32 + fq * 8, natc = pn * 256 + hd2 * 128 + i0;
            float b1[8], b2[8]; ld8(bias + natc, b1); ld8(bias + natc + 64, b2);
            const float sc = pn < 2 ? 0.08838834764831845f : 1.0f;
            bf16_t* outp = (bf16_t*)(ws + (pn < 2 ? WS_RQ : WS_RK)); const int oc = (pn & 1) * 256 + hd2 * 128 + i0;
            const float* cosT = (const float*)(ws + WS_COSR); const float* sinT = (const float*)(ws + WS_SINR);
#pragma unroll
            for (int ai = 0; ai < 2; ++ai)
#pragma unroll
                for (int m = 0; m < 4; ++m) {
                    const int row = rowb + ai * 128 + m * 16, pos = row & (SEQ - 1);
                    float c[8], s[8], x1[8], x2[8], o1[8], o2[8]; ld8(cosT + pos * 64 + i0, c); ld8(sinT + pos * 64 + i0, s); acc8(acc, ai, 0, m, x1); acc8(acc, ai, 1, m, x2);
#pragma unroll
                    for (int j = 0; j < 8; ++j) { const float a = x1[j] + b1[j], b = x2[j] + b2[j]; o1[j] = (a * c[j] - b * s[j]) * sc; o2[j] = (b * c[j] + a * s[j]) * sc; }
                    st8(outp + (size_t)row * 512 + oc, o1); st8(outp + (size_t)row * 512 + oc + 64, o2);
                }
        } else if (pn >= 12 && pn < 16) {
            const int i0 = fq * 8, natc = pn * 256 + wc * 64 + i0;
            float b1[8], b2[8]; ld8(bias + natc, b1); ld8(bias + natc + 32, b2);
            bf16_t* outp = (bf16_t*)(ws + WS_AQ); const int oc = (pn - 12) * 256 + wc * 64 + i0;
            const float* cosT = (const float*)(ws + WS_COSA); const float* sinT = (const float*)(ws + WS_SINA);
#pragma unroll
            for (int ai = 0; ai < 2; ++ai)
#pragma unroll
                for (int m = 0; m < 4; ++m) {
                    const int row = rowb + ai * 128 + m * 16, pos = row & (SEQ - 1);
                    float c[8], s[8], x1[8], x2[8], o1[8], o2[8]; ld8(cosT + pos * 32 + i0, c); ld8(sinT + pos * 32 + i0, s); acc8(acc, ai, 0, m, x1); acc8(acc, ai, 1, m, x2);
#pragma unroll
                    for (int j = 0; j < 8; ++j) { const float a = x1[j] + b1[j], b = x2[j] + b2[j]; o1[j] = (a * c[j] - b * s[j]) * 0.18033688011112042f; o2[j] = (b * c[j] + a * s[j]) * 0.18033688011112042f;     }
                    st8(outp + (size_t)row * 1024 + oc, o1); st8(outp + (size_t)row * 1024 + oc + 32, o2);
                }
        } else if (pn == 16) {
            const int hd = wc >> 1, i0 = (wc & 1) * 16 + fq * 4;
            const f32x4 b1 = *(const f32x4*)(bias + 4096 + hd * 64 + i0), b2 = *(const f32x4*)(bias + 4096 + hd * 64 + 32 + i0);
            float bv[8]; ld8(bias + 4224 + wc * 32 + fq * 8, bv);
            bf16_t* ak = (bf16_t*)(ws + WS_AK); bf16_t* av = (bf16_t*)(ws + WS_AV);
            const float* cosT = (const float*)(ws + WS_COSA); const float* sinT = (const float*)(ws + WS_SINA);
#pragma unroll
            for (int ai = 0; ai < 2; ++ai)
#pragma unroll
                for (int m = 0; m < 4; ++m) {
                    const int row = rowb + ai * 128 + m * 16, pos = row & (SEQ - 1);
                    const f32x4 c = *(const f32x4*)(cosT + pos * 32 + i0), s = *(const f32x4*)(sinT + pos * 32 + i0);
                    const f32x4 a = acc[ai][0][m][0] + b1, b = acc[ai][0][m][1] + b2;
                    const f32x4 o1 = a * c - b * s, o2 = b * c + a * s;
                    u32x2 w1, w2; w1.x = cvt_pk_bf16(o1[0], o1[1]); w1.y = cvt_pk_bf16(o1[2], o1[3]); w2.x = cvt_pk_bf16(o2[0], o2[1]); w2.y = cvt_pk_bf16(o2[2], o2[3]);
                    *(u32x2*)(ak + (size_t)row * 128 + hd * 64 + i0) = w1; *(u32x2*)(ak + (size_t)row * 128 + hd * 64 + 32 + i0) = w2;
                    float v[8]; acc8(acc, ai, 1, m, v);
#pragma unroll
                    for (int j = 0; j < 8; ++j) v[j] += bv[j];
                    st8(av + (size_t)row * 128 + wc * 32 + fq * 8, v);
                }
        } else {
            int act, ocb; bf16_t* outp;
            if (pn < 8) { act = 0; outp = (bf16_t*)(ws + WS_RV); ocb = (pn - 4) * 256; }
            else if (pn < 12) { act = 1; outp = (bf16_t*)(ws + WS_RG); ocb = (pn - 8) * 256; }
            else if (pn < 21) { act = 2; outp = (bf16_t*)(ws + WS_GA); ocb = (pn - 17) * 256; }
            else { act = 2; outp = (bf16_t*)(ws + WS_GB); ocb = (pn - 21) * 256; }
            const int c8 = wc * 32 + fq * 8;
#pragma unroll
            for (int bj = 0; bj < 2; ++bj) {
                float bv[8]; ld8(bias + pn * 256 + bj * 128 + c8, bv);
#pragma unroll
                for (int ai = 0; ai < 2; ++ai)
#pragma unroll
                    for (int m = 0; m < 4; ++m) {
                        const int row = rowb + ai * 128 + m * 16; float v[8]; acc8(acc, ai, bj, m, v);
#pragma unroll
                        for (int j = 0; j < 8; ++j) { float t = v[j] + bv[j]; const float sg = sigmoidf_(t); v[j] = act == 0 ? t : (act == 1 ? t * sg : sg); }
                        st8(outp + (size_t)row * 1024 + ocb + bj * 128 + c8, v);
                    }
            }
        }
    }
};

struct Epi2 {
    Ptrs P;
    __device__ __forceinline__ void operator()(const acc_t& acc, const pg8::Unit& u, int wr, int wc, int fr, int fq) const {
        unsigned char* ws = P.ws; const int rowb = u.pm * 256 + wr * 64 + fr, c8 = u.pn * 256 + wc * 32 + fq * 8;
        u32x4* pt = (u32x4*)((unsigned char*)P.out + (size_t)(u.pm * 4 + u.pn) * 131072) + threadIdx.x;
        const bf16_t* gate = (const bf16_t*)(ws + (u.sel ? WS_GB : WS_GA));
        bf16_t* mg = (bf16_t*)(ws + WS_MG);
#pragma unroll
        for (int ai = 0; ai < 2; ++ai)
#pragma unroll
            for (int m = 0; m < 4; ++m)
#pragma unroll
                for (int bj = 0; bj < 2; ++bj) {
                    const int row = rowb + ai * 128 + m * 16; const size_t off = (size_t)row * 1024 + c8 + bj * 128;
                    float gv[8], v[8]; ldbf8(gate + off, gv); acc8(acc, ai, bj, m, v);
                    u32x4* slot = pt + ((ai * 4 + m) * 2 + bj) * 512;
                    if (u.sel == 0) {
#pragma unroll
                        for (int j = 0; j < 8; ++j) v[j] *= gv[j];
                        u32x4 w; w.x = cvt_pk_bf16(v[0], v[1]); w.y = cvt_pk_bf16(v[2], v[3]); w.z = cvt_pk_bf16(v[4], v[5]); w.w = cvt_pk_bf16(v[6], v[7]); *slot = w;
                    } else {
                        float pv[8]; ldbf8((const bf16_t*)slot, pv);
#pragma unroll
                        for (int j = 0; j < 8; ++j) v[j] = pv[j] + v[j] * gv[j];
                        st8(mg + off, v);
                    }
                }
    }
};

struct Epi3 {
    Ptrs P;
    __device__ __forceinline__ void operator()(const acc_t& acc, const pg8::Unit& u, int wr, int wc, int fr, int fq) const {
        unsigned char* ws = P.ws; const int rowb = u.pm * 256 + wr * 64 + fr, c8 = u.pn * 256 + wc * 32 + fq * 8;
        bf16_t* x1b = (bf16_t*)(ws + WS_X1B); float* rs = (float*)(ws + WS_RS);
#pragma unroll
        for (int ai = 0; ai < 2; ++ai)
#pragma unroll
            for (int m = 0; m < 4; ++m) {
                const int row = rowb + ai * 128 + m * 16; float ss = 0.f;
#pragma unroll
                for (int bj = 0; bj < 2; ++bj) {
                    const size_t off = (size_t)row * 1024 + c8 + bj * 128; float xv[8], v[8]; ld8(P.x + off, xv); acc8(acc, ai, bj, m, v);
#pragma unroll
                    for (int j = 0; j < 8; ++j) { v[j] += xv[j]; ss += v[j] * v[j]; }
                    *(f32x4*)(P.out + off) = (f32x4){v[0], v[1], v[2], v[3]}; *(f32x4*)(P.out + off + 4) = (f32x4){v[4], v[5], v[6], v[7]};
                    st8(x1b + off, v);
                }
                ss += __shfl_xor(ss, 16); ss += __shfl_xor(ss, 32);
                if (fq == 0) rs[(size_t)row * 16 + u.pn * 4 + wc] = ss;
            }
    }
};

struct Epi4 {
    Ptrs P;
    __device__ __forceinline__ void operator()(const acc_t& acc, const pg8::Unit& u, int wr, int wc, int fr, int fq) const {
        unsigned char* ws = P.ws; const int rowb = u.pm * 256 + wr * 64 + fr, c8 = u.pn * 128 + wc * 32 + fq * 8;
        bf16_t* actp = (bf16_t*)(ws + WS_ACT); const float* rs = (const float*)(ws + WS_RS);
#pragma unroll
        for (int ai = 0; ai < 2; ++ai)
#pragma unroll
            for (int m = 0; m < 4; ++m) {
                const int row = rowb + ai * 128 + m * 16;
                const f32x4 r0 = *(const f32x4*)(rs + (size_t)row * 16), r1 = *(const f32x4*)(rs + (size_t)row * 16 + 4), r2 = *(const f32x4*)(rs + (size_t)row * 16 + 8), r3 = *(const f32x4*)(rs + (size_t)row * 16 + 12);
                const float ssum = ((r0[0] + r0[1]) + (r0[2] + r0[3])) + ((r1[0] + r1[1]) + (r1[2] + r1[3])) + ((r2[0] + r2[1]) + (r2[2] + r2[3])) + ((r3[0] + r3[1]) + (r3[2] + r3[3]));
                const float rn = 1.0f / sqrtf(ssum * (1.0f / 1024.0f) + EPS);
                float gv[8], uv[8], o[8]; acc8(acc, ai, 0, m, gv); acc8(acc, ai, 1, m, uv);
#pragma unroll
                for (int j = 0; j < 8; ++j) { const float gg = gv[j] * rn, uu = uv[j] * rn; o[j] = gg * sigmoidf_(gg) * uu; }
                st8(actp + (size_t)row * DFF + c8, o);
            }
    }
};

struct Epi5 {
    Ptrs P;
    __device__ __forceinline__ void operator()(const acc_t& acc, const pg8::Unit& u, int wr, int wc, int fr, int fq) const {
        const int rowb = u.pm * 256 + wr * 64 + fr, c8 = u.pn * 256 + wc * 32 + fq * 8;
#pragma unroll
        for (int ai = 0; ai < 2; ++ai)
#pragma unroll
            for (int m = 0; m < 4; ++m)
#pragma unroll
                for (int bj = 0; bj < 2; ++bj) {
                    const size_t off = (size_t)(rowb + ai * 128 + m * 16) * 1024 + c8 + bj * 128; float xv[8], v[8]; ld8(P.out + off, xv); acc8(acc, ai, bj, m, v);
                    *(f32x4*)(P.out + off) = (f32x4){v[0] + xv[0], v[1] + xv[1], v[2] + xv[2], v[3] + xv[3]}; *(f32x4*)(P.out + off + 4) = (f32x4){v[4] + xv[4], v[5] + xv[5], v[6] + xv[6], v[7] + xv[7]};
                }
    }
};

constexpr int NWAVES = 8;
constexpr int RING_OFF = 0, RING_BYTES = 131072;
constexpr int SCR_BYTES = 139264;
constexpr int LDSCTL_OFF = SCR_BYTES, MISC_OFF = LDSCTL_OFF + 320;
constexpr int LDS_BYTES = 147456;
#define RLX_AGENT __ATOMIC_RELAXED, __HIP_MEMORY_SCOPE_AGENT
#define LDS_WAIT() asm volatile("s_waitcnt lgkmcnt(0)" ::: "memory")
#define VM_WAIT() asm volatile("s_waitcnt vmcnt(0)" ::: "memory")

#define XB_TMO      128
#define XB_XCNT(j)  (256  + 64 * (j))
#define XB_XSUB(j)  (1280 + 64 * (j))
#define XB_XGEN(j)  (2304 + 64 * (j))
#define XB_TOP      3328
#define XB_TOPGEN   3392
#define XCD_BAR_WORDS 3456
#define XB_SPIN_CAP (1u << 22)
__device__ __forceinline__ unsigned xb_ld(unsigned* p)              { return __hip_atomic_load(p, __ATOMIC_RELAXED, __HIP_MEMORY_SCOPE_AGENT); }
__device__ __forceinline__ unsigned xb_add(unsigned* p, unsigned v) { return __hip_atomic_fetch_add(p, v, __ATOMIC_RELAXED, __HIP_MEMORY_SCOPE_AGENT); }
__device__ __forceinline__ unsigned xb_xcc_id() { return (unsigned)__builtin_amdgcn_s_getreg((3 << 11) | 20) & 0xFu; }
#define XB_SPIN(cond, bar) do { unsigned _sp = 0; while (cond) { __builtin_amdgcn_s_sleep(1); \
    if ((++_sp & 255u) == 0u) { if (xb_ld(&(bar)[XB_TMO])) break; if (_sp > XB_SPIN_CAP) { atomicAdd(&(bar)[XB_TMO], 1u); break; } } } } while (0)
struct XcdBarrier { unsigned* bar; unsigned x; volatile LAS unsigned* st; };
__device__ __forceinline__ XcdBarrier xcd_barrier_post(unsigned* bar, volatile LAS unsigned* st) {
    XcdBarrier b; b.bar = bar; b.x = xb_xcc_id(); b.st = st;
    if (threadIdx.x == 0) (void)xb_add(&bar[XB_XCNT(b.x)], 1u);
    return b;
}
__device__ __forceinline__ void xcd_barrier_complete(unsigned* bar, unsigned x, unsigned& nloc, unsigned& nx) {
    const unsigned G = gridDim.x * gridDim.y * gridDim.z;
    unsigned sum, cnt, mine, sp = 0u;
    for (;;) {
        sum = 0u; cnt = 0u; mine = 0u;
#pragma unroll
        for (unsigned j = 0; j < 16; ++j) { const unsigned c = xb_ld(&bar[XB_XCNT(j)]); sum += c; cnt += (c > 0u) ? 1u : 0u; mine = (j == x) ? c : mine; }
        if (sum == G) break;
        __builtin_amdgcn_s_sleep(1);
        if ((++sp & 255u) == 0u) { if (xb_ld(&bar[XB_TMO])) break; if (sp > XB_SPIN_CAP) { atomicAdd(&bar[XB_TMO], 1u); break; } }
    }
    nloc = mine > 0u ? mine : 1u; nx = cnt > 0u ? cnt : 1u;
}
__device__ __forceinline__ void xcd_barrier(const XcdBarrier& b) {
    asm volatile("s_waitcnt vmcnt(0)" ::: "memory");
    __syncthreads();
    if (threadIdx.x == 0) {
        unsigned* bar = b.bar;
        __builtin_amdgcn_s_waitcnt(0);
        unsigned nloc = b.st[0], nx = b.st[1];
        if (nloc == 0u) { xcd_barrier_complete(bar, b.x, nloc, nx); b.st[0] = nloc; b.st[1] = nx; }
        const unsigned old = xb_add(&bar[XB_XSUB(b.x)], 1u);
        const unsigned gen = old / nloc;
        if (old + 1u == (gen + 1u) * nloc) {
            __builtin_amdgcn_fence(__ATOMIC_RELEASE, "agent");
            asm volatile("s_waitcnt vmcnt(0)" ::: "memory");
            const unsigned og = xb_add(&bar[XB_TOP], 1u);
            const unsigned tg = og / nx;
            if (og + 1u == (tg + 1u) * nx) xb_add(&bar[XB_TOPGEN], 1u);
            else XB_SPIN(xb_ld(&bar[XB_TOPGEN]) == tg, bar);
            __builtin_amdgcn_fence(__ATOMIC_ACQUIRE, "agent");
            xb_add(&bar[XB_XGEN(b.x)], 1u);
            asm volatile("s_waitcnt vmcnt(0)" ::: "memory");
        } else {
            XB_SPIN(xb_ld(&bar[XB_XGEN(b.x)]) == gen, bar);
            __builtin_amdgcn_fence(__ATOMIC_ACQUIRE, "agent");
            asm volatile("s_waitcnt vmcnt(0)" ::: "memory");
        }
    }
    __syncthreads();
}

__device__ __forceinline__ int slot_col(int gm, int srow, int& which) {
    const int pn = srow >> 8, s = srow & 255, bj = s >> 7, wc = (s >> 5) & 3, n = (s >> 4) & 1, fq = (s >> 2) & 3, j = s & 3;
    which = 0;
    if (gm == 0) {
        if (pn < 4) return pn * 256 + (wc >> 1) * 128 + bj * 64 + (wc & 1) * 32 + fq * 8 + n * 4 + j;
        if (pn >= 12 && pn < 16) return pn * 256 + wc * 64 + bj * 32 + fq * 8 + n * 4 + j;
        if (pn == 16 && bj == 0) return 4096 + (wc >> 1) * 64 + n * 32 + (wc & 1) * 16 + fq * 4 + j;
    }
    if (gm == 4) { which = bj; return pn * 128 + wc * 32 + fq * 8 + n * 4 + j; }
    return pn * 256 + bj * 128 + wc * 32 + fq * 8 + n * 4 + j;
}
__device__ __forceinline__ void p0_transpose_item(const float* W0, const float* W1, int K, int N, const float* kscale, bf16_t* WT, int gm, LAS float* scr, int item, int lane) {
    const int nblk_k = K / 64, sb = item / nblk_k, kb = item % nblk_k, k0 = 64 * kb, s0 = 32 * sb;
    int which; const int col = slot_col(gm, s0 + (lane & 31), which); const float* W = which ? W1 : W0;
#pragma unroll 8
    for (int i = 0; i < 32; ++i) { const int kk = 2 * i + (lane >> 5); float v = W[(size_t)(k0 + kk) * N + col]; if (kscale) v *= kscale[k0 + kk]; scr[kk * 33 + (lane & 31)] = v; }
    LDS_WAIT(); asm volatile("" ::: "memory");
    const int c = lane & 7;
#pragma unroll
    for (int j = 0; j < 4; ++j) { const int n = (lane >> 3) + 8 * j; const LAS float* s = scr + (8 * c) * 33 + n;
        u32x4 o; o.x = pk2(s[0 * 33], s[1 * 33]); o.y = pk2(s[2 * 33], s[3 * 33]); o.z = pk2(s[4 * 33], s[5 * 33]); o.w = pk2(s[6 * 33], s[7 * 33]);
        *(u32x4*)(WT + (size_t)(s0 + n) * K + k0 + 8 * c) = o; }
    LDS_WAIT(); asm volatile("" ::: "memory");
}
__device__ __forceinline__ void sincos_d(double a, float& s, float& c) {
    const double k = rint(a * 0.63661977236758134308);
    double r = fma(-k, 1.57079632679489655800e+00, a); r = fma(-k, 6.12323399573676603587e-17, r);
    const double r2 = r * r;
    double sp = 1.0 / 6227020800.0; sp = fma(sp, r2, -1.0 / 39916800.0); sp = fma(sp, r2, 1.0 / 362880.0); sp = fma(sp, r2, -1.0 / 5040.0); sp = fma(sp, r2, 1.0 / 120.0); sp = fma(sp, r2, -1.0 / 6.0); sp = fma(sp * r2, r, r);
    double cp = 1.0 / 87178291200.0; cp = fma(cp, r2, -1.0 / 479001600.0); cp = fma(cp, r2, 1.0 / 3628800.0); cp = fma(cp, r2, -1.0 / 40320.0); cp = fma(cp, r2, 1.0 / 720.0); cp = fma(cp, r2, -1.0 / 24.0); cp = fma(cp, r2, 0.5); cp = fma(-cp, r2, 1.0);
    const int q = ((int)k) & 3;
    const double ss = (q & 1) ? cp : sp, cc = (q & 1) ? sp : cp;
    s = (float)((q & 2) ? -ss : ss); c = (float)(((q + 1) & 2) ? -cc : cc);
}

struct Frame {
    LAS unsigned char* lds; volatile LAS unsigned* MISC; gu32* ctl;
    int tid, lane, wave, vcu, G;
};

__device__ __forceinline__ void p0_prologue(const Frame& F, const float* const* in, const Ptrs& P) {
    unsigned char* ws = P.ws;
    LAS float* scr = (LAS float*)(F.lds + RING_OFF + F.wave * 16384);
    const int gw = F.vcu * NWAVES + F.wave, NGW = F.G * NWAVES;
    constexpr int I0 = (DIN / 32) * (D / 64), I1 = (D / 32) * (D / 64), I4 = (NGU / 32) * (D / 64), I5 = (D / 32) * (DFF / 64);
    constexpr int NITEMS = I0 + 3 * I1 + I4 + I5;
    for (int it = gw; it < NITEMS; it += NGW) {
        int r = it;
        if (r < I0) { p0_transpose_item(in[2], nullptr, D, DIN, nullptr, (bf16_t*)(ws + WS_W1), 0, scr, r, F.lane); continue; } r -= I0;
        if (r < I1) { p0_transpose_item(in[5], nullptr, D, D, nullptr, (bf16_t*)(ws + WS_WR), 1, scr, r, F.lane); continue; } r -= I1;
        if (r < I1) { p0_transpose_item(in[7], nullptr, D, D, nullptr, (bf16_t*)(ws + WS_WA), 2, scr, r, F.lane); continue; } r -= I1;
        if (r < I1) { p0_transpose_item(in[8], nullptr, D, D, nullptr, (bf16_t*)(ws + WS_WO), 3, scr, r, F.lane); continue; } r -= I1;
        if (r < I4) { p0_transpose_item(in[10], in[11], D, DFF, in[9], (bf16_t*)(ws + WS_WGU), 4, scr, r, F.lane); continue; } r -= I4;
        p0_transpose_item(in[12], nullptr, DFF, D, nullptr, (bf16_t*)(ws + WS_WD), 5, scr, r, F.lane);
    }
    {
        float* cosR = (float*)(ws + WS_COSR); float* sinR = (float*)(ws + WS_SINR); float* cosA = (float*)(ws + WS_COSA); float* sinA = (float*)(ws + WS_SINA);
        const int gt = F.vcu * (NWAVES * 64) + F.tid, NGT = F.G * NWAVES * 64;
        for (int e = gt; e < SEQ * 64; e += NGT) {
            const int pos = e >> 6, i = e & 63;
            double inv = 1.0; for (int k = 0; k < i; ++k) inv *= 0.8659643233600653;
            float s, c; sincos_d((double)pos * inv, s, c);
            cosR[e] = c; sinR[e] = s;
            if ((i & 1) == 0) { cosA[pos * 32 + (i >> 1)] = c; sinA[pos * 32 + (i >> 1)] = s; }
        }
    }
    {
        const float* g1 = in[1]; bf16_t* H1 = (bf16_t*)P.out;
        f32x4 gv[4];
#pragma unroll
        for (int j = 0; j < 4; ++j) gv[j] = *((const f32x4*)g1 + F.lane + 64 * j);
        for (int m = gw; m < M; m += NGW) {
            const f32x4* xr = (const f32x4*)(P.x + (size_t)m * D) + F.lane;
            f32x4 v[4]; float s = 0.f;
#pragma unroll
            for (int j = 0; j < 4; ++j) { v[j] = xr[64 * j]; s += (v[j].x * v[j].x + v[j].y * v[j].y) + (v[j].z * v[j].z + v[j].w * v[j].w); }
            const float rn = 1.0f / sqrtf(wave_sum(s) * (1.0f / D) + EPS);
            unsigned long long* o8 = (unsigned long long*)(H1 + (size_t)m * D) + F.lane;
#pragma unroll
            for (int j = 0; j < 4; ++j) { const f32x4 y = v[j] * rn * gv[j]; o8[64 * j] = (unsigned long long)cvt_pk_bf16(y.x, y.y) | ((unsigned long long)cvt_pk_bf16(y.z, y.w) << 32); }
        }
    }
}

__device__ __forceinline__ void p2_attention_simple(const Frame& F, const Ptrs& P) {
    unsigned char* ws = P.ws;
    bf16_t* AQ = (bf16_t*)(ws + WS_AQ); const bf16_t* AK = (const bf16_t*)(ws + WS_AK); const bf16_t* AV = (const bf16_t*)(ws + WS_AV);
    const int gw = F.vcu * NWAVES + F.wave, NGW = F.G * NWAVES, lane = F.lane;
    for (int task = gw; task < M * AH; task += NGW) {
        const int row = task >> 4, hd = task & 15, kvh = hd >> 3, t = row & (SEQ - 1);
        float q[64];
        { const u32x4* qp = (const u32x4*)(AQ + (size_t)row * 1024 + hd * 64);
#pragma unroll
          for (int i = 0; i < 8; ++i) { const u32x4 w = qp[i]; q[8 * i] = bf_lo(w.x); q[8 * i + 1] = bf_hi(w.x); q[8 * i + 2] = bf_lo(w.y); q[8 * i + 3] = bf_hi(w.y); q[8 * i + 4] = bf_lo(w.z); q[8 * i + 5] = bf_hi(w.z); q[8 * i + 6] = bf_lo(w.w); q[8 * i + 7] = bf_hi(w.w); } }
        float sc[2];
#pragma unroll
        for (int h = 0; h < 2; ++h) {
            const int kk = lane + 64 * h; float s = -1e30f;
            if (kk <= t) {
                const u32x4* kp = (const u32x4*)(AK + (size_t)(row - kk) * 128 + kvh * 64); s = 0.f;
#pragma unroll
                for (int i = 0; i < 8; ++i) { const u32x4 w = kp[i]; s += q[8 * i] * bf_lo(w.x) + q[8 * i + 1] * bf_hi(w.x) + q[8 * i + 2] * bf_lo(w.y) + q[8 * i + 3] * bf_hi(w.y) + q[8 * i + 4] * bf_lo(w.z) + q[8 * i + 5] * bf_hi(w.z) + q[8 * i + 6] * bf_lo(w.w) + q[8 * i + 7] * bf_hi(w.w); }
            }
            sc[h] = s;
        }
        const float sink = P.sinks[hd] * 1.4426950408889634f;
        const float mx = fmaxf(wave_max(fmaxf(sc[0], sc[1])), sink);
        const float e0 = exp2f(sc[0] - mx), e1 = exp2f(sc[1] - mx);
        const float den = wave_sum(e0 + e1) + exp2f(sink - mx);
        float o = 0.f;
        const int nk = t + 1 < 128 ? t + 1 : 128;
        for (int kk = 0; kk < nk; ++kk) {
            const float p = __shfl(kk < 64 ? e0 : e1, kk & 63);
            o += p * bf2f(AV[(size_t)(row - kk) * 128 + kvh * 64 + lane]);
        }
        o /= den;
        AQ[(size_t)row * 1024 + hd * 64 + lane] = (bf16_t)f2bf(o);
    }
}

__device__ __forceinline__ void p2_retkv_simple(const Frame& F, const Ptrs& P) {
    unsigned char* ws = P.ws;
    const bf16_t* RK = (const bf16_t*)(ws + WS_RK); const bf16_t* RV = (const bf16_t*)(ws + WS_RV); bf16_t* KV = (bf16_t*)P.out;
    LAS float* Kl = (LAS float*)(F.lds + RING_OFF);
    const int tid = F.tid;
    for (int task = blockIdx.x; task < NB * RH * NCH; task += F.G) {
        const int n = task & (NCH - 1), h = (task >> 6) & 3, b = task >> 8; const int r0 = b * SEQ + n * RC;
        const float lg = ret_log2_gamma(h);
        __syncthreads();
        for (int i = tid; i < 128 * 128; i += 512) { const int s = i >> 7, d = i & 127; Kl[i] = bf2f(RK[(size_t)(r0 + s) * 512 + h * 128 + d]) * exp2f(lg * (float)(127 - s)); }
        __syncthreads();
        const int e = tid & 255, dh = tid >> 8;
        float acc[64];
#pragma unroll
        for (int i = 0; i < 64; ++i) acc[i] = 0.f;
        for (int s = 0; s < 128; ++s) {
            const float v = bf2f(RV[(size_t)(r0 + s) * 1024 + h * 256 + e]);
            const LAS f32x4* kr = (const LAS f32x4*)(Kl + s * 128 + dh * 64);
#pragma unroll
            for (int i = 0; i < 16; ++i) { const f32x4 k4 = kr[i]; acc[4 * i] += k4[0] * v; acc[4 * i + 1] += k4[1] * v; acc[4 * i + 2] += k4[2] * v; acc[4 * i + 3] += k4[3] * v; }
        }
        bf16_t* op = KV + ((size_t)task * 256 + e) * 128 + dh * 64;
#pragma unroll
        for (int i = 0; i < 8; ++i) { u32x4 w; w.x = cvt_pk_bf16(acc[8 * i], acc[8 * i + 1]); w.y = cvt_pk_bf16(acc[8 * i + 2], acc[8 * i + 3]); w.z = cvt_pk_bf16(acc[8 * i + 4], acc[8 * i + 5]); w.w = cvt_pk_bf16(acc[8 * i + 6], acc[8 * i + 7]); *(u32x4*)(op + 8 * i) = w; }
    }
}


typedef float f32x16 __attribute__((ext_vector_type(16)));
typedef short s16x4 __attribute__((ext_vector_type(4)));
typedef __bf16 bf16x2_t __attribute__((ext_vector_type(2)));
#define MFMA32(a, b, c) __builtin_amdgcn_mfma_f32_32x32x16_bf16((a), (b), (c), 0, 0, 0)
__device__ __forceinline__ int crow(int r, int h) { return (r & 3) + 8 * (r >> 2) + 4 * h; }
__device__ __forceinline__ unsigned cvtpk(float lo, float hi) { f32x2 v = {lo, hi}; bf16x2_t b = __builtin_convertvector(v, bf16x2_t); return __builtin_bit_cast(unsigned, b); }
__device__ __forceinline__ bf16x8 pack8(const f32x16& x, int s) { u32x4 p; p.x = cvtpk(x[8 * s], x[8 * s + 1]); p.y = cvtpk(x[8 * s + 2], x[8 * s + 3]); p.z = cvtpk(x[8 * s + 4], x[8 * s + 5]); p.w = cvtpk(x[8 * s + 6], x[8 * s + 7]); return __builtin_bit_cast(bf16x8, p); }
__device__ __forceinline__ s16x4 tr_rd(const LAS unsigned char* p) { return __builtin_bit_cast(s16x4, __builtin_amdgcn_ds_read_tr16_b64_v4i16((LAS s16x4*)p)); }
__device__ __forceinline__ bf16x8 tr_frag(const LAS unsigned char* trbase, int pitch, int k_lo, int k_hi, int col0) {
    const s16x4 lo = tr_rd(trbase + k_lo * pitch + col0 * 2), hi = tr_rd(trbase + k_hi * pitch + col0 * 2);
    return (bf16x8){lo[0], lo[1], lo[2], lo[3], hi[0], hi[1], hi[2], hi[3]};
}

constexpr int ATT_KP = 144, ATT_VP = 192, ATT_SP = 144;
constexpr int ATT_K_OFF = 0, ATT_V_OFF = 256 * ATT_KP, ATT_S_OFF = ATT_V_OFF + 256 * ATT_VP;
__device__ __forceinline__ void p2_attention(const Frame& F, const Ptrs& P) {
    unsigned char* ws = P.ws;
    bf16_t* AQ = (bf16_t*)(ws + WS_AQ); const bf16_t* AK = (const bf16_t*)(ws + WS_AK); const bf16_t* AV = (const bf16_t*)(ws + WS_AV);
    const int tid = F.tid, lane = F.lane, wave = F.wave, r32 = lane & 31, hh = lane >> 5;
    LAS unsigned char* Kl = F.lds + ATT_K_OFF; LAS unsigned char* Vl = F.lds + ATT_V_OFF; LAS unsigned char* Sl = F.lds + ATT_S_OFF + wave * (32 * ATT_SP);
    const LAS unsigned char* vtr = Vl + ((lane & 15) >> 2) * ATT_VP + (16 * ((lane >> 4) & 1) + 4 * (lane & 3)) * 2;
    for (int unit = blockIdx.x; unit < NB * (SEQ / 128) * AKV; unit += F.G) {
        const int kvh = unit & 1, nb = (unit >> 1) & 63, b = unit >> 7; const int row0 = b * SEQ + nb * 128;
        __syncthreads();
        for (int i = tid; i < 256 * 8; i += 512) {
            const int key = i >> 3, ch = i & 7; if (nb == 0 && key < 128) continue;
            const size_t g = (size_t)(row0 - 128 + key) * 128 + kvh * 64 + ch * 8;
            *(LAS u32x4*)(Kl + key * ATT_KP + ch * 16) = *(const u32x4*)(AK + g);
            *(LAS u32x4*)(Vl + key * ATT_VP + ch * 16) = *(const u32x4*)(AV + g);
        }
        __syncthreads();
        const int head = kvh * 8 + wave;
        const float sink2 = P.sinks[head] * 1.4426950408889634f;
#pragma unroll 1
        for (int qt = 0; qt < 4; ++qt) {
            bf16x8 qf[4];
            { const bf16_t* qp = AQ + (size_t)(row0 + 32 * qt + r32) * 1024 + head * 64 + 8 * hh;
#pragma unroll
              for (int ks = 0; ks < 4; ++ks) qf[ks] = *(const bf16x8*)(qp + 16 * ks); }
            f32x16 sc[5];
#pragma unroll
            for (int t = 0; t < 5; ++t) {
                const int kt = qt + t;
                if (nb == 0 && kt < 4) {
#pragma unroll
                    for (int r = 0; r < 16; ++r) sc[t][r] = -1e30f;
                } else {
                    const LAS unsigned char* kp = Kl + (32 * kt + r32) * ATT_KP + 16 * hh;
                    f32x16 a;
#pragma unroll
                    for (int r = 0; r < 16; ++r) a[r] = 0.f;
#pragma unroll
                    for (int ks = 0; ks < 4; ++ks) a = MFMA32(*(const LAS bf16x8*)(kp + 32 * ks), qf[ks], a);
                    if (t == 0) {
#pragma unroll
                        for (int r = 0; r < 16; ++r) if (crow(r, hh) <= r32) a[r] = -1e30f;
                    }
                    if (t == 4) {
#pragma unroll
                        for (int r = 0; r < 16; ++r) if (crow(r, hh) > r32) a[r] = -1e30f;
                    }
                    sc[t] = a;
                }
            }
            float m = sink2;
#pragma unroll
            for (int t = 0; t < 5; ++t)
#pragma unroll
                for (int r = 0; r < 16; ++r) m = fmaxf(m, sc[t][r]);
            m = fmaxf(m, __shfl_xor(m, 32));
            float l = 0.f;
#pragma unroll
            for (int t = 0; t < 5; ++t)
#pragma unroll
                for (int r = 0; r < 16; ++r) { const float p = exp2f(sc[t][r] - m); sc[t][r] = p; l += p; }
            l += __shfl_xor(l, 32);
            l += exp2f(sink2 - m);
            f32x16 o[2];
#pragma unroll
            for (int r = 0; r < 16; ++r) { o[0][r] = 0.f; o[1][r] = 0.f; }
#pragma unroll
            for (int t = 0; t < 5; ++t) {
                const int kt = qt + t;
                if (!(nb == 0 && kt < 4)) {
#pragma unroll
                    for (int s2 = 0; s2 < 2; ++s2) {
                        const bf16x8 pb = pack8(sc[t], s2);
                        const int k0 = 32 * kt + 16 * s2 + 4 * hh;
#pragma unroll
                        for (int dt = 0; dt < 2; ++dt) o[dt] = MFMA32(tr_frag(vtr, ATT_VP, k0, k0 + 8, 32 * dt), pb, o[dt]);
                    }
                }
            }
            const float rl = 1.0f / l;
#pragma unroll
            for (int dt = 0; dt < 2; ++dt)
#pragma unroll
                for (int g = 0; g < 4; ++g) {
                    u32x2 w; w.x = cvtpk(o[dt][4 * g] * rl, o[dt][4 * g + 1] * rl); w.y = cvtpk(o[dt][4 * g + 2] * rl, o[dt][4 * g + 3] * rl);
                    *(LAS u32x2*)(Sl + r32 * ATT_SP + (32 * dt + 8 * g + 4 * hh) * 2) = w;
                }
#pragma unroll
            for (int i = 0; i < 4; ++i) {
                const int rr = i * 8 + (lane >> 3), ch = lane & 7;
                const u32x4 v = *(const LAS u32x4*)(Sl + rr * ATT_SP + ch * 16);
                *(u32x4*)(AQ + (size_t)(row0 + 32 * qt + rr) * 1024 + head * 64 + ch * 8) = v;
            }
        }
    }
}

constexpr int RKV_KP = 320, RKV_VP = 576;
constexpr int RKV_K_OFF = 0, RKV_V_OFF = 128 * RKV_KP;
__device__ __forceinline__ void p2_retkv(const Frame& F, const Ptrs& P) {
    unsigned char* ws = P.ws;
    const bf16_t* RK = (const bf16_t*)(ws + WS_RK); const bf16_t* RV = (const bf16_t*)(ws + WS_RV); bf16_t* KV = (bf16_t*)P.out;
    const int tid = F.tid, lane = F.lane, wave = F.wave, r32 = lane & 31, hh = lane >> 5;
    LAS unsigned char* Kl = F.lds + RKV_K_OFF; LAS unsigned char* Vl = F.lds + RKV_V_OFF;
    const int troff = (16 * ((lane >> 4) & 1) + 4 * (lane & 3)) * 2, trq = (lane & 15) >> 2;
    const LAS unsigned char* ktr = Kl + trq * RKV_KP + troff; const LAS unsigned char* vtr = Vl + trq * RKV_VP + troff;
    for (int task = blockIdx.x; task < NB * RH * NCH; task += F.G) {
        const int n = task & (NCH - 1), h = (task >> 6) & 3, b = task >> 8; const int r0 = b * SEQ + n * RC;
        const float lg = ret_log2_gamma(h);
        __syncthreads();
        for (int i = tid; i < 128 * 16; i += 512) {
            const int s = i >> 4, ch = i & 15; float v[8]; ldbf8(RK + (size_t)(r0 + s) * 512 + h * 128 + ch * 8, v);
            const float f = exp2f(lg * (float)(127 - s));
            u32x4 w; w.x = cvtpk(v[0] * f, v[1] * f); w.y = cvtpk(v[2] * f, v[3] * f); w.z = cvtpk(v[4] * f, v[5] * f); w.w = cvtpk(v[6] * f, v[7] * f);
            *(LAS u32x4*)(Kl + s * RKV_KP + ch * 16) = w;
        }
        for (int i = tid; i < 128 * 32; i += 512) { const int s = i >> 5, ch = i & 31; *(LAS u32x4*)(Vl + s * RKV_VP + ch * 16) = *(const u32x4*)(RV + (size_t)(r0 + s) * 1024 + h * 256 + ch * 8); }
        __syncthreads();
        f32x16 acc[4];
#pragma unroll
        for (int dt = 0; dt < 4; ++dt)
#pragma unroll
            for (int r = 0; r < 16; ++r) acc[dt][r] = 0.f;
#pragma unroll 2
        for (int ks = 0; ks < 8; ++ks) {
            const int k0 = 16 * ks + 8 * hh;
            const bf16x8 vb = tr_frag(vtr, RKV_VP, k0, k0 + 4, 32 * wave);
#pragma unroll
            for (int dt = 0; dt < 4; ++dt) acc[dt] = MFMA32(tr_frag(ktr, RKV_KP, k0, k0 + 4, 32 * dt), vb, acc[dt]);
        }
        bf16_t* op = KV + ((size_t)task * 256 + 32 * wave + r32) * 128;
#pragma unroll
        for (int dt = 0; dt < 4; ++dt)
#pragma unroll
            for (int g = 0; g < 4; ++g) {
                u32x2 w; w.x = cvtpk(acc[dt][4 * g], acc[dt][4 * g + 1]); w.y = cvtpk(acc[dt][4 * g + 2], acc[dt][4 * g + 3]);
                *(u32x2*)(op + 32 * dt + 8 * g + 4 * hh) = w;
            }
    }
}

__device__ __forceinline__ void p3_scan(const Frame& F, const Ptrs& P) {
    const bf16_t* KV = (const bf16_t*)P.out; bf16_t* S = (bf16_t*)((unsigned char*)P.out + 64 * MiB);
    const int gt = F.vcu * (NWAVES * 64) + F.tid, NGT = F.G * NWAVES * 64;
    for (int it = gt; it < NB * RH * (RDV * RDK / 8); it += NGT) {
        const int bh = it >> 12, el = (it & 4095) * 8; const int h = bh & 3;
        const float cd = exp2f(ret_log2_gamma(h) * 128.0f);
        float st[8];
#pragma unroll
        for (int j = 0; j < 8; ++j) st[j] = 0.f;
        const size_t base = (size_t)bh * NCH * 32768 + el;
#pragma unroll 4
        for (int n = 0; n < NCH; ++n) {
            float kv[8]; ldbf8(KV + base + (size_t)n * 32768, kv);
            st8(S + base + (size_t)n * 32768, st);
#pragma unroll
            for (int j = 0; j < 8; ++j) st[j] = st[j] * cd + kv[j];
        }
    }
}

__device__ __forceinline__ void p4_retout_simple(const Frame& F, const Ptrs& P) {
    unsigned char* ws = P.ws;
    const bf16_t* RQ = (const bf16_t*)(ws + WS_RQ); const bf16_t* RK = (const bf16_t*)(ws + WS_RK); const bf16_t* RV = (const bf16_t*)(ws + WS_RV); bf16_t* RG = (bf16_t*)(ws + WS_RG);
    const bf16_t* S = (const bf16_t*)((unsigned char*)P.out + 64 * MiB);
    LAS unsigned* Ql = (LAS unsigned*)(F.lds + RING_OFF);
    LAS unsigned* Kl = (LAS unsigned*)(F.lds + RING_OFF + 32768);
    LAS float* Pl = (LAS float*)(F.lds + RING_OFF + 66048);
    const int tid = F.tid, lane = F.lane, wave = F.wave;
    for (int task = blockIdx.x; task < NB * RH * NCH; task += F.G) {
        const int n = task & (NCH - 1), h = (task >> 6) & 3, b = task >> 8; const int r0 = b * SEQ + n * RC;
        const float lg = ret_log2_gamma(h);
        __syncthreads();
        for (int i = tid; i < 128 * 64; i += 512) { const int s = i >> 6, d2 = i & 63;
            Ql[s * 64 + d2] = *(const unsigned*)(RQ + (size_t)(r0 + s) * 512 + h * 128 + 2 * d2);
            Kl[s * 65 + d2] = *(const unsigned*)(RK + (size_t)(r0 + s) * 512 + h * 128 + 2 * d2); }
        __syncthreads();
        {
            const int s = tid & 127, cq = tid >> 7; float a[32];
#pragma unroll
            for (int i = 0; i < 32; ++i) a[i] = 0.f;
            for (int d2 = 0; d2 < 64; ++d2) {
                const unsigned kw = Kl[s * 65 + d2]; const float k0 = bf_lo(kw), k1 = bf_hi(kw);
#pragma unroll
                for (int i = 0; i < 32; ++i) { const unsigned qw = Ql[(cq * 32 + i) * 64 + d2]; a[i] += bf_lo(qw) * k0 + bf_hi(qw) * k1; }
            }
#pragma unroll
            for (int i = 0; i < 32; ++i) { const int c = cq * 32 + i; Pl[c * 128 + s] = c >= s ? a[i] * exp2f(lg * (float)(c - s)) : 0.f; }
        }
        __syncthreads();
        const int e = tid & 255, ch = tid >> 8;
        LAS float* red = (LAS float*)(F.lds + RING_OFF + 131584);
        const float gg = P.rg_g[h * 256 + e];
#pragma unroll 1
        for (int pass = 0; pass < 2; ++pass) {
            const int cb = pass * 64 + ch * 32;
            float acc[32], acc2[32];
#pragma unroll
            for (int i = 0; i < 32; ++i) { acc[i] = 0.f; acc2[i] = 0.f; }
            for (int s = 0; s < 128; ++s) {
                const float v = bf2f(RV[(size_t)(r0 + s) * 1024 + h * 256 + e]);
#pragma unroll
                for (int i = 0; i < 32; ++i) acc[i] += Pl[(cb + i) * 128 + s] * v;
            }
            const bf16_t* sp = S + ((size_t)task * 256 + e) * 128;
            for (int d2 = 0; d2 < 64; ++d2) {
                const unsigned sw = *(const unsigned*)(sp + 2 * d2); const float s0 = bf_lo(sw), s1 = bf_hi(sw);
#pragma unroll
                for (int i = 0; i < 32; ++i) { const unsigned qw = Ql[(cb + i) * 64 + d2]; acc2[i] += bf_lo(qw) * s0 + bf_hi(qw) * s1; }
            }
#pragma unroll
            for (int i = 0; i < 32; ++i) {
                acc[i] += exp2f(lg * (float)(cb + i + 1)) * acc2[i];
                const float s1 = wave_sum(acc[i]), s2 = wave_sum(acc[i] * acc[i]);
                if (lane == 0) { red[((cb + i) * 4 + (wave & 3)) * 2] = s1; red[((cb + i) * 4 + (wave & 3)) * 2 + 1] = s2; }
            }
            __syncthreads();
#pragma unroll
            for (int i = 0; i < 32; ++i) {
                const LAS f32x4* rp = (const LAS f32x4*)(red + (cb + i) * 8); const f32x4 ra = rp[0], rb = rp[1];
                const float mean = ((ra[0] + ra[2]) + (rb[0] + rb[2])) * (1.0f / 256.0f), ex2 = ((ra[1] + ra[3]) + (rb[1] + rb[3])) * (1.0f / 256.0f);
                const float rstd = 1.0f / sqrtf(fmaxf(ex2 - mean * mean, 0.f) + EPS);
                bf16_t* gp = RG + (size_t)(r0 + cb + i) * 1024 + h * 256 + e;
                *gp = (bf16_t)f2bf((acc[i] - mean) * rstd * gg * bf2f(*gp));
            }
        }
    }
}

constexpr int R3_QP = 272, R3_VP = 576, R3_TP = 528;
constexpr int R3_A_OFF = 0, R3_B_OFF = 128 * R3_QP, R3_ST_OFF = R3_B_OFF + 128 * R3_VP;
static_assert(256 * R3_QP <= 128 * R3_VP && R3_ST_OFF + 2048 <= SCR_BYTES && 128 * R3_TP <= R3_ST_OFF, "R3 LDS map");
__device__ __forceinline__ void p4_retout(const Frame& F, const Ptrs& P) {
    unsigned char* ws = P.ws;
    const bf16_t* RQ = (const bf16_t*)(ws + WS_RQ); const bf16_t* RK = (const bf16_t*)(ws + WS_RK); const bf16_t* RV = (const bf16_t*)(ws + WS_RV); bf16_t* RG = (bf16_t*)(ws + WS_RG);
    const bf16_t* S = (const bf16_t*)((unsigned char*)P.out + 64 * MiB);
    const int tid = F.tid, lane = F.lane, wave = F.wave, r32 = lane & 31, hh = lane >> 5;
    const int eh = wave >> 2, cg = wave < 4 ? wave : 7 - wave;
    LAS unsigned char* Al = F.lds + R3_A_OFF; LAS unsigned char* Bl = F.lds + R3_B_OFF; LAS f32x2* stats = (LAS f32x2*)(F.lds + R3_ST_OFF);
    const LAS unsigned char* vtr = Bl + ((lane & 15) >> 2) * R3_VP + (16 * ((lane >> 4) & 1) + 4 * (lane & 3)) * 2;
    for (int task = blockIdx.x; task < NB * RH * NCH; task += F.G) {
        const int n = task & (NCH - 1), h = (task >> 6) & 3, b = task >> 8; const int r0 = b * SEQ + n * RC;
        const float lg = ret_log2_gamma(h);
        __syncthreads();
        for (int i = tid; i < 128 * 16; i += 512) { const int s = i >> 4, ch = i & 15; *(LAS u32x4*)(Al + s * R3_QP + ch * 16) = *(const u32x4*)(RQ + (size_t)(r0 + s) * 512 + h * 128 + ch * 8); }
        for (int i = tid; i < 256 * 16; i += 512) { const int e = i >> 4, ch = i & 15; *(LAS u32x4*)(Bl + e * R3_QP + ch * 16) = *(const u32x4*)(S + ((size_t)task * 256 + e) * 128 + ch * 8); }
        __syncthreads();
        bf16x8 qf[8];
#pragma unroll
        for (int ks = 0; ks < 8; ++ks) qf[ks] = *(const LAS bf16x8*)(Al + (32 * cg + r32) * R3_QP + (16 * ks + 8 * hh) * 2);
        f32x16 acc[4];
#pragma unroll
        for (int et = 0; et < 4; ++et) {
            f32x16 a;
#pragma unroll
            for (int r = 0; r < 16; ++r) a[r] = 0.f;
            const LAS unsigned char* sp = Bl + (128 * eh + 32 * et + r32) * R3_QP + 16 * hh;
#pragma unroll
            for (int ks = 0; ks < 8; ++ks) a = MFMA32(*(const LAS bf16x8*)(sp + 32 * ks), qf[ks], a);
            acc[et] = a;
        }
        const int c = 32 * cg + r32;
        { const float qd = exp2f(lg * (float)(c + 1));
#pragma unroll
          for (int et = 0; et < 4; ++et)
#pragma unroll
              for (int r = 0; r < 16; ++r) acc[et][r] *= qd; }
        __syncthreads();
        for (int i = tid; i < 128 * 16; i += 512) { const int s = i >> 4, ch = i & 15; *(LAS u32x4*)(Al + s * R3_QP + ch * 16) = *(const u32x4*)(RK + (size_t)(r0 + s) * 512 + h * 128 + ch * 8); }
        for (int i = tid; i < 128 * 32; i += 512) { const int s = i >> 5, ch = i & 31; *(LAS u32x4*)(Bl + s * R3_VP + ch * 16) = *(const u32x4*)(RV + (size_t)(r0 + s) * 1024 + h * 256 + ch * 8); }
        __syncthreads();
#pragma unroll 1
        for (int st = 0; st <= cg; ++st) {
            f32x16 x;
#pragma unroll
            for (int r = 0; r < 16; ++r) x[r] = 0.f;
            const LAS unsigned char* kp = Al + (32 * st + r32) * R3_QP + 16 * hh;
#pragma unroll
            for (int ks = 0; ks < 8; ++ks) x = MFMA32(*(const LAS bf16x8*)(kp + 32 * ks), qf[ks], x);
#pragma unroll
            for (int r = 0; r < 16; ++r) { const int dl = c - (32 * st + crow(r, hh)); x[r] = dl >= 0 ? x[r] * exp2f(lg * (float)dl) : 0.f; }
#pragma unroll
            for (int s2 = 0; s2 < 2; ++s2) {
                const bf16x8 pb = pack8(x, s2);
                const int k0 = 32 * st + 16 * s2 + 4 * hh;
#pragma unroll
                for (int et = 0; et < 4; ++et) acc[et] = MFMA32(tr_frag(vtr, R3_VP, k0, k0 + 8, 128 * eh + 32 * et), pb, acc[et]);
            }
        }
        float s1 = 0.f;
#pragma unroll
        for (int et = 0; et < 4; ++et)
#pragma unroll
            for (int r = 0; r < 16; ++r) s1 += acc[et][r];
        s1 += __shfl_xor(s1, 32);
        const float mw = s1 * (1.0f / 128.0f);
        float q2 = 0.f;
#pragma unroll
        for (int et = 0; et < 4; ++et)
#pragma unroll
            for (int r = 0; r < 16; ++r) { const float d = acc[et][r] - mw; q2 += d * d; }
        q2 += __shfl_xor(q2, 32);
        if (hh == 0) stats[c * 2 + eh] = (f32x2){mw, q2};
        __syncthreads();
        const f32x2 sa = stats[c * 2], sb = stats[c * 2 + 1];
        const float mean = 0.5f * (sa.x + sb.x), dm = sb.x - sa.x;
        const float rstd = 1.0f / sqrtf((sa.y + sb.y + dm * dm * 64.0f) * (1.0f / 256.0f) + EPS);
#pragma unroll
        for (int et = 0; et < 4; ++et)
#pragma unroll
            for (int g = 0; g < 4; ++g) {
                u32x2 w; w.x = cvtpk((acc[et][4 * g] - mean) * rstd, (acc[et][4 * g + 1] - mean) * rstd); w.y = cvtpk((acc[et][4 * g + 2] - mean) * rstd, (acc[et][4 * g + 3] - mean) * rstd);
                *(LAS u32x2*)(Al + c * R3_TP + (128 * eh + 32 * et + 8 * g + 4 * hh) * 2) = w;
            }
        __syncthreads();
#pragma unroll
        for (int i = 0; i < 8; ++i) {
            const int chunk = i * 512 + tid, cc = chunk >> 5, e8 = (chunk & 31) * 8;
            float v[8], gg[8], rg[8]; ldbf8((const LAS bf16_t*)(Al + cc * R3_TP + e8 * 2), v); ld8(P.rg_g + h * 256 + e8, gg);
            bf16_t* gp = RG + (size_t)(r0 + cc) * 1024 + h * 256 + e8; ldbf8(gp, rg);
#pragma unroll
            for (int j = 0; j < 8; ++j) v[j] = v[j] * gg[j] * rg[j];
            st8(gp, v);
        }
    }
}

__device__ __forceinline__ void p9_final_norm(const Frame& F, const Ptrs& P) {
    const int gw = F.vcu * NWAVES + F.wave, NGW = F.G * NWAVES;
    f32x4 gv[4];
#pragma unroll
    for (int j = 0; j < 4; ++j) gv[j] = *((const f32x4*)P.lnf_g + F.lane + 64 * j);
    for (int m = gw; m < M; m += NGW) {
        f32x4* xr = (f32x4*)(P.out + (size_t)m * D) + F.lane;
        f32x4 v[4]; float s = 0.f;
#pragma unroll
        for (int j = 0; j < 4; ++j) { v[j] = xr[64 * j]; s += (v[j].x * v[j].x + v[j].y * v[j].y) + (v[j].z * v[j].z + v[j].w * v[j].w); }
        const float rn = 1.0f / sqrtf(wave_sum(s) * (1.0f / D) + EPS);
#pragma unroll
        for (int j = 0; j < 4; ++j) xr[64 * j] = v[j] * rn * gv[j];
    }
}

constexpr int PER_PHASE = 10;
constexpr int N_LAUNCHES = MK_N_LAUNCHES;
struct Args { const float* in[14]; float* out; unsigned char* ws; int ph_lo, ph_hi, li, pad; };

__global__ void __launch_bounds__(NWAVES * 64, 2) fwd_kernel(Args args) {
    extern __shared__ __attribute__((aligned(16))) unsigned char lds[];
    Frame F;
    F.lds = (LAS unsigned char*)lds;
    F.MISC = (volatile LAS unsigned*)(F.lds + MISC_OFF);
    F.tid = threadIdx.x; F.lane = F.tid & 63; F.wave = __builtin_amdgcn_readfirstlane(F.tid >> 6);
    F.G = gridDim.x; { const int bx = blockIdx.x; F.vcu = (F.G % 8 == 0) ? (bx % 8) * (F.G / 8) + bx / 8 : bx; }
    unsigned char* ws = args.ws;
    F.ctl = (gu32*)(ws + WS_CTL);
    Ptrs P; P.x = args.in[0]; P.b_in = args.in[3]; P.rg_g = args.in[4]; P.sinks = args.in[6]; P.lnf_g = args.in[13]; P.out = args.out; P.ws = ws;
    for (int u = F.tid; u < (LDS_BYTES - LDSCTL_OFF) / 4; u += NWAVES * 64) ((LAS unsigned*)(F.lds + LDSCTL_OFF))[u] = 0u;
    __syncthreads();
    XcdBarrier bar; bar.bar = (unsigned*)(F.ctl + CW_BAR); bar.x = 0; bar.st = nullptr;
    if (N_LAUNCHES == 1) bar = xcd_barrier_post((unsigned*)(F.ctl + CW_BAR), F.MISC + 8);
#define GRID_BAR() do { if (N_LAUNCHES == 1) xcd_barrier(bar); } while (0)
    const int lo = args.ph_lo, hi = args.ph_hi;
#define IN(k) (lo <= (k) && (k) < hi)
#define BOTH(k) (IN(k) && IN((k) + 1))
    using namespace pg8;
    if (IN(0)) { p0_prologue(F, args.in, P); if (BOTH(0)) GRID_BAR(); }
    if (IN(1)) {
        Gemm g{(const bf16_t*)P.out, (const bf16_t*)(ws + WS_W1), nullptr, nullptr, D}; StaticOrder S; S.init(M, DIN, F.G, (int)blockIdx.x);
        Epi1 E{P}; gemm_phase<Epi1, StaticOrder, true, true>(F.lds + RING_OFF, g, S, E);
        if (BOTH(1)) GRID_BAR();
    }
    if (IN(2)) { p2_attention(F, P); p2_retkv(F, P); if (BOTH(2)) GRID_BAR(); }
    if (IN(3)) { p3_scan(F, P); if (BOTH(3)) GRID_BAR(); }
    if (IN(4)) { p4_retout(F, P); if (BOTH(4)) GRID_BAR(); }
    if (IN(5)) {
        Gemm g{(const bf16_t*)(ws + WS_RG), (const bf16_t*)(ws + WS_WR), (const bf16_t*)(ws + WS_AQ), (const bf16_t*)(ws + WS_WA), D}; DualOrder S; S.init(M, D, F.G, (int)blockIdx.x);
        Epi2 E{P}; gemm_phase<Epi2, DualOrder, true, true>(F.lds + RING_OFF, g, S, E);
        if (BOTH(5)) GRID_BAR();
    }
    if (IN(6)) {
        Gemm g{(const bf16_t*)(ws + WS_MG), (const bf16_t*)(ws + WS_WO), nullptr, nullptr, D}; StaticOrder S; S.init(M, D, F.G, (int)blockIdx.x);
        Epi3 E{P}; gemm_phase<Epi3, StaticOrder, true, true>(F.lds + RING_OFF, g, S, E);
        if (BOTH(6)) GRID_BAR();
    }
    if (IN(7)) {
        Gemm g{(const bf16_t*)(ws + WS_X1B), (const bf16_t*)(ws + WS_WGU), nullptr, nullptr, D}; StaticOrder S; S.init(M, NGU, F.G, (int)blockIdx.x);
        Epi4 E{P}; gemm_phase<Epi4, StaticOrder, true, true>(F.lds + RING_OFF, g, S, E);
        if (BOTH(7)) GRID_BAR();
    }
    if (IN(8)) {
        Gemm g{(const bf16_t*)(ws + WS_ACT), (const bf16_t*)(ws + WS_WD), nullptr, nullptr, DFF}; StaticOrder S; S.init(M, D, F.G, (int)blockIdx.x);
        Epi5 E{P}; gemm_phase<Epi5, StaticOrder, true, true>(F.lds + RING_OFF, g, S, E);
        if (BOTH(8)) GRID_BAR();
    }
    if (IN(9)) { p9_final_norm(F, P); }
#undef IN
#undef BOTH
}

extern "C" void kernel_launch(void* const* d_in, const int* in_sizes, int n_in, void* d_out, int out_size, void* d_ws, size_t ws_size, hipStream_t stream) {
    static int grid = 0;
    if (grid == 0) {
        if (n_in != 14 || in_sizes[0] != M * D || out_size != M * D || ws_size < WS_END) { fprintf(stderr, "kernel_launch: unexpected shapes (n_in %d, in0 %d, out %d, ws %zu); nothing launched\n", n_in, n_in > 0 ? in_sizes[0] : -1, out_size, ws_size); grid = -1; return; }
        int dev = 0, cus = 0, per_cu = 0;
        if (hipGetDevice(&dev) != hipSuccess || hipDeviceGetAttribute(&cus, hipDeviceAttributeMultiprocessorCount, dev) != hipSuccess) { grid = -1; return; }
        if (hipFuncSetAttribute((const void*)fwd_kernel, hipFuncAttributeMaxDynamicSharedMemorySize, LDS_BYTES) != hipSuccess) { fprintf(stderr, "kernel_launch: hipFuncSetAttribute failed\n"); grid = -1; return; }
        if (hipOccupancyMaxActiveBlocksPerMultiprocessor(&per_cu, (const void*)fwd_kernel, NWAVES * 64, LDS_BYTES) != hipSuccess || per_cu < 1) { fprintf(stderr, "kernel_launch: occupancy query says %d blocks per CU\n", per_cu); }
        (void)hipGetLastError();
        grid = cus;
    }
    if (grid < 0) return;
    (void)hipMemsetAsync((char*)d_ws + WS_CTL, 0, CTL_ZERO_BYTES, stream);
    Args a{};
    for (int i = 0; i < 14; ++i) a.in[i] = (const float*)d_in[i];
    a.out = (float*)d_out; a.ws = (unsigned char*)d_ws;
    for (int li = 0; li < N_LAUNCHES; ++li) {
        a.ph_lo = (N_LAUNCHES == 1) ? 0 : li; a.ph_hi = (N_LAUNCHES == 1) ? PER_PHASE : li + 1; a.li = li;
        hipLaunchKernelGGL(fwd_kernel, dim3(grid), dim3(NWAVES * 64), LDS_BYTES, stream, a);
    }
}
```

```cpp
#include <hip/hip_runtime.h>
#include <cstdio>
#include <cstdint>

#ifndef MK_DUP
#define MK_DUP (-1)
#endif
#ifndef MK_N_LAUNCHES
#define MK_N_LAUNCHES 1
#endif

constexpr int NB = 4, SEQ = 8192, D = 1024, M = NB * SEQ;
constexpr int DIN = 6400, DFF = 2816, NGU = 2 * DFF;
constexpr int RH = 4, RDK = 128, RDV = 256, RC = 128, NCH = SEQ / RC;
constexpr int AH = 16, AKV = 2, AD = 64, AWIN = 128;
constexpr float EPS = 1e-6f;

#define LAS __attribute__((address_space(3)))
#define GAS __attribute__((address_space(1)))
typedef unsigned short bf16_t;
typedef short bf16x8 __attribute__((ext_vector_type(8)));
typedef float f32x4 __attribute__((ext_vector_type(4)));
typedef float f32x2 __attribute__((ext_vector_type(2)));
typedef unsigned u32x4 __attribute__((ext_vector_type(4)));
typedef unsigned u32x2 __attribute__((ext_vector_type(2)));
typedef GAS unsigned gu32;

__device__ __forceinline__ unsigned cvt_pk_bf16(float lo, float hi) { unsigned r; asm volatile("v_cvt_pk_bf16_f32 %0, %1, %2" : "=v"(r) : "v"(lo), "v"(hi)); return r; }
__device__ __forceinline__ float bf_lo(unsigned w) { return __uint_as_float(w << 16); }
__device__ __forceinline__ float bf_hi(unsigned w) { return __uint_as_float(w & 0xffff0000u); }
__device__ __forceinline__ float bf2f(bf16_t v) { return __uint_as_float((unsigned)v << 16); }
__device__ __forceinline__ unsigned f2bf(float f) { unsigned u = __builtin_bit_cast(unsigned, f); return (u + 0x7fffu + ((u >> 16) & 1u)) >> 16; }
__device__ __forceinline__ unsigned pk2(float lo, float hi) { return f2bf(lo) | (f2bf(hi) << 16); }
__device__ __forceinline__ float rsqrtf_(float v) { return __builtin_amdgcn_rsqf(v); }
__device__ __forceinline__ float sigmoidf_(float v) { return __builtin_amdgcn_rcpf(1.0f + __builtin_amdgcn_exp2f(-1.4426950408889634f * v)); }
__device__ __forceinline__ float wave_sum(float v) {
#pragma unroll
    for (int o = 1; o < 64; o <<= 1) v += __shfl_xor(v, o);
    return v;
}
__device__ __forceinline__ float wave_max(float v) {
#pragma unroll
    for (int o = 1; o < 64; o <<= 1) v = fmaxf(v, __shfl_xor(v, o));
    return v;
}

__device__ __forceinline__ float ret_log2_gamma(int h) { return log2f(1.0f - exp2f(-5.0f - (float)h)); }

constexpr size_t MiB = 1u << 20;
constexpr size_t WS_CTL = 0, CTL_ZERO_BYTES = 64 * 1024;
constexpr size_t WS_W1 = 1 * MiB;
constexpr size_t WS_WR = 14 * MiB;
constexpr size_t WS_WA = 16 * MiB;
constexpr size_t WS_WO = 18 * MiB;
constexpr size_t WS_WGU = 20 * MiB;
constexpr size_t WS_WD = 31 * MiB;
constexpr size_t WS_COSR = 37 * MiB, WS_SINR = 39 * MiB, WS_COSA = 41 * MiB, WS_SINA = 42 * MiB;
constexpr size_t WS_RS = 43 * MiB;
constexpr size_t WS_RQ = 48 * MiB;
constexpr size_t WS_RK = 80 * MiB;
constexpr size_t WS_RV = 112 * MiB;
constexpr size_t WS_RG = 176 * MiB;
constexpr size_t WS_AQ = 240 * MiB;
constexpr size_t WS_AK = 304 * MiB;
constexpr size_t WS_AV = 312 * MiB;
constexpr size_t WS_GA = 320 * MiB;
constexpr size_t WS_GB = 384 * MiB;
constexpr size_t WS_END = 448 * MiB;
constexpr size_t WS_MG = WS_RQ;
constexpr size_t WS_X1B = WS_RV;
constexpr size_t WS_ACT = WS_RG;
static_assert(WS_ACT + (size_t)M * DFF * 2 <= WS_END, "act overlay");

constexpr int CW_TMO = 0, CW_CODE = 1, CW_BAR = 1024;

namespace pg8 {
#define PG8_LAS __attribute__((address_space(3)))
constexpr int BM = 256, BK = 64, HALF = 128, HTB = HALF * BK * 2, STAGE_BYTES = 8 * HTB, NXCD = 8, WGM = 8;
__host__ __device__ __forceinline__ int lds_byte(int r, int c) { const int st = (r >> 4) * 2 + (c >> 5), rr = r & 15, cc = c & 31, ob = rr * 64 + cc * 2; return st * 1024 + (ob ^ (((ob >> 9) & 1) << 5)); }
__host__ __device__ __forceinline__ void stage_rc(int b, int& R, int& C) { const int st = b / 1024, sb = b % 1024, swz = sb ^ (((sb >> 9) & 1) << 5); R = (st >> 1) * 16 + swz / 64; C = (st & 1) * 32 + (swz % 64) / 2; }

struct Unit { int pm, pn, sel; };
struct Gemm { const bf16_t* A0; const bf16_t* B0; const bf16_t* A1; const bf16_t* B1; int K; };

struct StaticOrder {
    int nM, nN, nwg, G, c;
    __device__ void init(int M_, int N_, int G_, int c_) { nM = M_ / BM; nN = N_ / BM; nwg = nM * nN; G = G_; c = c_; }
    __device__ bool tile(int i, Unit& u) const {
        const long L = (long)i * G + c; if (L >= nwg) return false;
        int wgid = (int)L; { const int q = nwg / NXCD, r = nwg % NXCD, xcd = wgid % NXCD, off = wgid / NXCD; wgid = (xcd < r ? xcd * (q + 1) : r * (q + 1) + (xcd - r) * q) + off; }
        const int nig = WGM * nN, gid = wgid / nig, fm = gid * WGM, gsz = (nM - fm) < WGM ? (nM - fm) : WGM;
        u.pm = fm + ((wgid % nig) % gsz); u.pn = (wgid % nig) / gsz; u.sel = 0; return true;
    }
    __device__ bool next(int i, Unit& u) const { return tile(i, u); }
};
struct DualOrder : StaticOrder {
    __device__ bool next(int i, Unit& u) const { if (!tile(i >> 1, u)) return false; u.sel = i & 1; return true; }
};

template <class Epi, class Sched, bool ALIGN_EPI, bool SP2, int PH = 0>
__device__ __forceinline__ void gemm_phase(PG8_LAS unsigned char* lds, const Gemm g, const Sched& S, const Epi& E) {
    const int tid = threadIdx.x, wid = __builtin_amdgcn_readfirstlane(tid >> 6), lane = tid & 63, wr = wid >> 2, wc = wid & 3, fr = lane & 15, fq = lane >> 4;
    const int K = g.K, nt = K / BK;
    unsigned voffA[2];
#pragma unroll
    for (int i = 0; i < 2; ++i) { int R, C; stage_rc(tid * 16 + i * 8192, R, C); voffA[i] = (unsigned)(R * K + C) * 2u; }
    const size_t kstep = (size_t)(BK * 2);
    const size_t hstep = (size_t)HALF * K * 2;
    const size_t tstep = 2 * hstep;
    const unsigned ldsw = (unsigned)wid * 1024u;
    const int aoff = lds_byte(wr * 64 + fr, fq * 8), boff = lds_byte(wc * 32 + fr, fq * 8);
#define PG8_SA(b, h) (((b) * 2 + (h)) * HTB)
#define PG8_SB(b, h) ((4 + (b) * 2 + (h)) * HTB)
#define PG8_STAGE(bufoff, gbase) do { _Pragma("unroll") for (int _i = 0; _i < 2; ++_i) \
        __builtin_amdgcn_global_load_lds((const unsigned*)((const char*)(gbase) + voffA[_i]), (PG8_LAS unsigned*)(lds + (bufoff) + ldsw + _i * 8192), 16, 0, 0); } while (0)
#define PG8_LDA(dst, b, h) do { _Pragma("unroll") for (int m = 0; m < 4; ++m) _Pragma("unroll") for (int k = 0; k < 2; ++k) dst[m][k] = *(const PG8_LAS bf16x8*)(lds + PG8_SA(b, h) + aoff + m * 2048 + k * 1024); } while (0)
#define PG8_LDB(dst, b, h) do { _Pragma("unroll") for (int n = 0; n < 2; ++n) _Pragma("unroll") for (int k = 0; k < 2; ++k) dst[n][k] = *(const PG8_LAS bf16x8*)(lds + PG8_SB(b, h) + boff + n * 2048 + k * 1024); } while (0)
#define PG8_MMA(ai, bj, At, Bt) do { __builtin_amdgcn_s_setprio(1); _Pragma("unroll") for (int m = 0; m < 4; ++m) _Pragma("unroll") for (int n = 0; n < 2; ++n) _Pragma("unroll") for (int k = 0; k < 2; ++k) \
        acc[ai][bj][m][n] = __builtin_amdgcn_mfma_f32_16x16x32_bf16(Bt[n][k], At[m][k], acc[ai][bj][m][n], 0, 0, 0); __builtin_amdgcn_s_setprio(0); } while (0)
#define PG8_WAIT_V(n) asm volatile("s_waitcnt vmcnt(" #n ")" ::: "memory")
#define PG8_WAIT_L(n) asm volatile("s_waitcnt lgkmcnt(" #n ")" ::: "memory")
#define PG8_BAR __builtin_amdgcn_s_barrier()
#define PG8_SCHED __builtin_amdgcn_sched_barrier(0)
#define PG8_ABASE(u) ((const char*)((u).sel ? g.A1 : g.A0) + (size_t)(u).pm * tstep)
#define PG8_BBASE(u) ((const char*)((u).sel ? g.B1 : g.B0) + (size_t)(u).pn * tstep)
    Unit cur, nxt; int ui = 0;
    if (!S.next(0, cur)) return;
    f32x4 acc[2][2][4][2];
#pragma unroll
    for (int a = 0; a < 2; ++a)
#pragma unroll
        for (int b = 0; b < 2; ++b)
#pragma unroll
            for (int m = 0; m < 4; ++m)
#pragma unroll
                for (int n = 0; n < 2; ++n) acc[a][b][m][n] = (f32x4){0.f, 0.f, 0.f, 0.f};
    bf16x8 At[4][2], B0[2][2], B1[2][2];
    const char* cA = PG8_ABASE(cur); const char* cB = PG8_BBASE(cur);
    if constexpr (SP2) {
        PG8_STAGE(PG8_SB(0, 0), cB); PG8_STAGE(PG8_SB(0, 1), cB + hstep); PG8_STAGE(PG8_SA(0, 0), cA); PG8_STAGE(PG8_SA(0, 1), cA + hstep);
        if (wr == 1) PG8_BAR;
        PG8_WAIT_V(2); PG8_BAR;
        PG8_STAGE(PG8_SB(1, 0), cB + kstep); PG8_STAGE(PG8_SA(1, 0), cA + kstep); PG8_STAGE(PG8_SB(1, 1), cB + hstep + kstep);
        PG8_WAIT_V(6); PG8_BAR;
    } else {
        PG8_STAGE(PG8_SB(0, 0), cB); PG8_STAGE(PG8_SA(0, 0), cA); PG8_STAGE(PG8_SB(0, 1), cB + hstep); PG8_STAGE(PG8_SA(0, 1), cA + hstep);
        if (wr == 1) PG8_BAR;
        PG8_WAIT_V(4); PG8_BAR;
        PG8_STAGE(PG8_SB(1, 0), cB + kstep); PG8_STAGE(PG8_SA(1, 0), cA + kstep); PG8_STAGE(PG8_SB(1, 1), cB + hstep + kstep);
        PG8_WAIT_V(6); PG8_BAR;
    }
    for (;;) {
        const bool has_next = S.next(ui + 1, nxt);
        const char* nA = has_next ? PG8_ABASE(nxt) : cA; const char* nB = has_next ? PG8_BBASE(nxt) : cB;
        for (int t = 0; t < nt; t += 2) {
            const bool last = (t == nt - 2);
            const char* a1 = cA + (size_t)(t + 1) * kstep;
            const char* a2 = last ? nA : cA + (size_t)(t + 2) * kstep; const char* b2 = last ? nB : cB + (size_t)(t + 2) * kstep;
            const char* a3 = a2 + kstep; const char* b3 = b2 + kstep;
            if constexpr (SP2) {
            PG8_LDB(B0, 0, 0); PG8_LDB(B1, 0, 1); PG8_SCHED; PG8_LDA(At, 0, 0); PG8_STAGE(PG8_SA(1, 1), a1 + hstep);
            PG8_WAIT_V(8); PG8_WAIT_L(0); PG8_BAR; PG8_MMA(0, 0, At, B0); PG8_MMA(0, 1, At, B1); PG8_BAR; PG8_SCHED;
            PG8_LDA(At, 0, 1); PG8_STAGE(PG8_SB(0, 0), b2); PG8_STAGE(PG8_SB(0, 1), b2 + hstep); PG8_STAGE(PG8_SA(0, 0), a2);
            PG8_WAIT_V(8); PG8_WAIT_L(0); PG8_BAR; PG8_MMA(1, 0, At, B0); PG8_MMA(1, 1, At, B1); PG8_BAR; PG8_SCHED;
            PG8_LDB(B0, 1, 0); PG8_LDB(B1, 1, 1); PG8_SCHED; PG8_LDA(At, 1, 0); PG8_STAGE(PG8_SA(0, 1), a2 + hstep);
            PG8_WAIT_V(8); PG8_WAIT_L(0); PG8_BAR; PG8_MMA(0, 0, At, B0); PG8_MMA(0, 1, At, B1); PG8_BAR; PG8_SCHED;
            PG8_LDA(At, 1, 1); PG8_STAGE(PG8_SB(1, 0), b3); PG8_STAGE(PG8_SB(1, 1), b3 + hstep); PG8_STAGE(PG8_SA(1, 0), a3);
            PG8_WAIT_V(8); PG8_WAIT_L(0); PG8_BAR; PG8_MMA(1, 0, At, B0); PG8_MMA(1, 1, At, B1); PG8_BAR; PG8_SCHED;
            } else {
            PG8_LDB(B0, 0, 0); PG8_SCHED; PG8_LDA(At, 0, 0); PG8_STAGE(PG8_SA(1, 1), a1 + hstep);
            PG8_WAIT_L(8); PG8_BAR; PG8_WAIT_L(0); PG8_MMA(0, 0, At, B0); PG8_BAR; PG8_SCHED;
            PG8_LDB(B1, 0, 1); PG8_STAGE(PG8_SB(0, 0), b2);
            PG8_BAR; PG8_WAIT_L(0); PG8_MMA(0, 1, At, B1); PG8_BAR;
            PG8_LDA(At, 0, 1); PG8_STAGE(PG8_SA(0, 0), a2);
            PG8_BAR; PG8_WAIT_L(0); PG8_MMA(1, 0, At, B0); PG8_BAR; PG8_SCHED;
            PG8_STAGE(PG8_SB(0, 1), b2 + hstep);
            PG8_WAIT_V(6); PG8_BAR; PG8_MMA(1, 1, At, B1); PG8_BAR;
            PG8_LDB(B0, 1, 0); PG8_SCHED; PG8_LDA(At, 1, 0); PG8_STAGE(PG8_SA(0, 1), a2 + hstep);
            PG8_WAIT_L(8); PG8_BAR; PG8_WAIT_L(0); PG8_MMA(0, 0, At, B0); PG8_BAR; PG8_SCHED;
            PG8_LDB(B1, 1, 1); PG8_STAGE(PG8_SB(1, 0), b3);
            PG8_BAR; PG8_WAIT_L(0); PG8_MMA(0, 1, At, B1); PG8_BAR;
            PG8_LDA(At, 1, 1); PG8_STAGE(PG8_SA(1, 0), a3);
            PG8_BAR; PG8_WAIT_L(0); PG8_MMA(1, 0, At, B0); PG8_BAR; PG8_SCHED;
            PG8_STAGE(PG8_SB(1, 1), b3 + hstep);
            PG8_WAIT_V(6); PG8_BAR; PG8_MMA(1, 1, At, B1); PG8_BAR;
            }
        }
        if constexpr (ALIGN_EPI) { if (wr == 0) PG8_BAR; }
        int efr = fr, efq = fq, ewr = wr, ewc = wc;
        asm volatile("" : "+v"(efr), "+v"(efq), "+s"(ewr), "+s"(ewc));
        if constexpr (MK_DUP == 30 + PH) E(acc, cur, ewr, ewc, efr, efq);
        E(acc, cur, ewr, ewc, efr, efq);
        if (!has_next) break;
#pragma unroll
        for (int a = 0; a < 2; ++a)
#pragma unroll
            for (int b = 0; b < 2; ++b)
#pragma unroll
                for (int m = 0; m < 4; ++m)
#pragma unroll
                    for (int n = 0; n < 2; ++n) acc[a][b][m][n] = (f32x4){0.f, 0.f, 0.f, 0.f};
        cur = nxt; cA = nA; cB = nB; ++ui;
        if constexpr (ALIGN_EPI) { if (wr == 1) PG8_BAR; }
    }
    PG8_WAIT_V(0);
    if constexpr (!ALIGN_EPI) { if (wr == 0) PG8_BAR; }
    PG8_BAR;
#undef PG8_SA
#undef PG8_SB
#undef PG8_STAGE
#undef PG8_LDA
#undef PG8_LDB
#undef PG8_MMA
#undef PG8_WAIT_V
#undef PG8_WAIT_L
#undef PG8_BAR
#undef PG8_SCHED
#undef PG8_ABASE
#undef PG8_BBASE
}
}

typedef f32x4 acc_t[2][2][4][2];

struct Ptrs {
    const float* x; const float* b_in; const float* rg_g; const float* sinks; const float* lnf_g;
    float* out; unsigned char* ws; float fz;
};
__device__ __forceinline__ void ld8(const float* p, float (&v)[8]) { const f32x4 a = *(const f32x4*)p, b = *(const f32x4*)(p + 4); v[0] = a[0]; v[1] = a[1]; v[2] = a[2]; v[3] = a[3]; v[4] = b[0]; v[5] = b[1]; v[6] = b[2]; v[7] = b[3]; }
__device__ __forceinline__ void ldbf8(const bf16_t* p, float (&v)[8]) { const u32x4 w = *(const u32x4*)p; v[0] = bf_lo(w.x); v[1] = bf_hi(w.x); v[2] = bf_lo(w.y); v[3] = bf_hi(w.y); v[4] = bf_lo(w.z); v[5] = bf_hi(w.z); v[6] = bf_lo(w.w); v[7] = bf_hi(w.w); }
__device__ __forceinline__ void ldbf8(const LAS bf16_t* p, float (&v)[8]) { const u32x4 w = *(const LAS u32x4*)p; v[0] = bf_lo(w.x); v[1] = bf_hi(w.x); v[2] = bf_lo(w.y); v[3] = bf_hi(w.y); v[4] = bf_lo(w.z); v[5] = bf_hi(w.z); v[6] = bf_lo(w.w); v[7] = bf_hi(w.w); }
__device__ __forceinline__ void st8(bf16_t* p, const float (&v)[8]) { u32x4 w; w.x = cvt_pk_bf16(v[0], v[1]); w.y = cvt_pk_bf16(v[2], v[3]); w.z = cvt_pk_bf16(v[4], v[5]); w.w = cvt_pk_bf16(v[6], v[7]); *(u32x4*)p = w; }
__device__ __forceinline__ void acc8(const acc_t& acc, int ai, int bj, int m, float (&v)[8]) { const f32x4 a = acc[ai][bj][m][0], b = acc[ai][bj][m][1]; v[0] = a[0]; v[1] = a[1]; v[2] = a[2]; v[3] = a[3]; v[4] = b[0]; v[5] = b[1]; v[6] = b[2]; v[7] = b[3]; }

struct Epi1 {
    Ptrs P;
    __device__ __forceinline__ void operator()(const acc_t& acc, const pg8::Unit& u, int wr, int wc, int fr, int fq) const {
        unsigned char* ws = P.ws; const int pn = u.pn; const int rowb = u.pm * 256 + wr * 64 + fr;
        const float* bias = P.b_in;
        if (pn < 4) {
            const int hd2 = wc >> 1, i0 = (wc & 1) * 32 + fq * 8, natc = pn * 256 + hd2 * 128 + i0;
            float b1[8], b2[8]; ld8(bias + natc, b1); ld8(bias + natc + 64, b2);
            const float sc = pn < 2 ? 0.08838834764831845f : 1.0f;
            bf16_t* outp = (bf16_t*)(ws + (pn < 2 ? WS_RQ : WS_RK)); const int oc = (pn & 1) * 256 + hd2 * 128 + i0;
            const float* cosT = (const float*)(ws + WS_COSR); const float* sinT = (const float*)(ws + WS_SINR);
#pragma unroll
            for (int ai = 0; ai < 2; ++ai)
#pragma unroll
                for (int m = 0; m < 4; ++m) {
                    const int row = rowb + ai * 128 + m * 16, pos = row & (SEQ - 1);
                    float c[8], s[8], x1[8], x2[8], o1[8], o2[8]; ld8(cosT + pos * 64 + i0, c); ld8(sinT + pos * 64 + i0, s); acc8(acc, ai, 0, m, x1); acc8(acc, ai, 1, m, x2);
#pragma unroll
                    for (int j = 0; j < 8; ++j) { const float a = x1[j] + b1[j], b = x2[j] + b2[j]; o1[j] = (a * c[j] - b * s[j]) * sc; o2[j] = (b * c[j] + a * s[j]) * sc; }
                    st8(outp + (size_t)row * 512 + oc, o1); st8(outp + (size_t)row * 512 + oc + 64, o2);
                }
        } else if (pn >= 12 && pn < 16) {
            const int i0 = fq * 8, natc = pn * 256 + wc * 64 + i0;
            float b1[8], b2[8]; ld8(bias + natc, b1); ld8(bias + natc + 32, b2);
            bf16_t* outp = (bf16_t*)(ws + WS_AQ); const int oc = (pn - 12) * 256 + wc * 64 + i0;
            const float* cosT = (const float*)(ws + WS_COSA); const float* sinT = (const float*)(ws + WS_SINA);
#pragma unroll
            for (int ai = 0; ai < 2; ++ai)
#pragma unroll
                for (int m = 0; m < 4; ++m) {
                    const int row = rowb + ai * 128 + m * 16, pos = row & (SEQ - 1);
                    float c[8], s[8], x1[8], x2[8], o1[8], o2[8]; ld8(cosT + pos * 32 + i0, c); ld8(sinT + pos * 32 + i0, s); acc8(acc, ai, 0, m, x1); acc8(acc, ai, 1, m, x2);
#pragma unroll
                    for (int j = 0; j < 8; ++j) { const float a = x1[j] + b1[j], b = x2[j] + b2[j]; o1[j] = (a * c[j] - b * s[j]) * 0.18033688011112042f; o2[j] = (b * c[j] + a * s[j]) * 0.18033688011112042f;     }
                    st8(outp + (size_t)row * 1024 + oc, o1); st8(outp + (size_t)row * 1024 + oc + 32, o2);
                }
        } else if (pn == 16) {
            const int hd = wc >> 1, i0 = (wc & 1) * 16 + fq * 4;
            const f32x4 b1 = *(const f32x4*)(bias + 4096 + hd * 64 + i0), b2 = *(const f32x4*)(bias + 4096 + hd * 64 + 32 + i0);
            float bv[8]; ld8(bias + 4224 + wc * 32 + fq * 8, bv);
            bf16_t* ak = (bf16_t*)(ws + WS_AK); bf16_t* av = (bf16_t*)(ws + WS_AV);
            const float* cosT = (const float*)(ws + WS_COSA); const float* sinT = (const float*)(ws + WS_SINA);
#pragma unroll
            for (int ai = 0; ai < 2; ++ai)
#pragma unroll
                for (int m = 0; m < 4; ++m) {
                    const int row = rowb + ai * 128 + m * 16, pos = row & (SEQ - 1);
                    const f32x4 c = *(const f32x4*)(cosT + pos * 32 + i0), s = *(const f32x4*)(sinT + pos * 32 + i0);
                    const f32x4 a = acc[ai][0][m][0] + b1, b = acc[ai][0][m][1] + b2;
                    const f32x4 o1 = a * c - b * s, o2 = b * c + a * s;
                    u32x2 w1, w2; w1.x = cvt_pk_bf16(o1[0], o1[1]); w1.y = cvt_pk_bf16(o1[2], o1[3]); w2.x = cvt_pk_bf16(o2[0], o2[1]); w2.y = cvt_pk_bf16(o2[2], o2[3]);
                    *(u32x2*)(ak + (size_t)row * 128 + hd * 64 + i0) = w1; *(u32x2*)(ak + (size_t)row * 128 + hd * 64 + 32 + i0) = w2;
                    float v[8]; acc8(acc, ai, 1, m, v);
#pragma unroll
                    for (int j = 0; j < 8; ++j) v[j] += bv[j];
                    st8(av + (size_t)row * 128 + wc * 32 + fq * 8, v);
                }
        } else {
            int act, ocb; bf16_t* outp;
            if (pn < 8) { act = 0; outp = (bf16_t*)(ws + WS_RV); ocb = (pn - 4) * 256; }
            else if (pn < 12) { act = 1; outp = (bf16_t*)(ws + WS_RG); ocb = (pn - 8) * 256; }
            else if (pn < 21) { act = 2; outp = (bf16_t*)(ws + WS_GA); ocb = (pn - 17) * 256; }
            else { act = 2; outp = (bf16_t*)(ws + WS_GB); ocb = (pn - 21) * 256; }
            const int c8 = wc * 32 + fq * 8;
#pragma unroll
            for (int bj = 0; bj < 2; ++bj) {
                float bv[8]; ld8(bias + pn * 256 + bj * 128 + c8, bv);
#pragma unroll
                for (int ai = 0; ai < 2; ++ai)
#pragma unroll
                    for (int m = 0; m < 4; ++m) {
                        const int row = rowb + ai * 128 + m * 16; float v[8]; acc8(acc, ai, bj, m, v);
#pragma unroll
                        for (int j = 0; j < 8; ++j) { float t = v[j] + bv[j]; const float sg = sigmoidf_(t); v[j] = act == 0 ? t : (act == 1 ? t * sg : sg); }
                        st8(outp + (size_t)row * 1024 + ocb + bj * 128 + c8, v);
                    }
            }
        }
    }
};

struct Epi2 {
    Ptrs P;
    __device__ __forceinline__ void operator()(const acc_t& acc, const pg8::Unit& u, int wr, int wc, int fr, int fq) const {
        unsigned char* ws = P.ws; const int rowb = u.pm * 256 + wr * 64 + fr, c8 = u.pn * 256 + wc * 32 + fq * 8;
        u32x4* pt = (u32x4*)((unsigned char*)P.out + (size_t)(u.pm * 4 + u.pn) * 131072) + threadIdx.x;
        const bf16_t* gate = (const bf16_t*)(ws + (u.sel ? WS_GB : WS_GA));
        bf16_t* mg = (bf16_t*)(ws + WS_MG);
#pragma unroll
        for (int ai = 0; ai < 2; ++ai)
#pragma unroll
            for (int m = 0; m < 4; ++m)
#pragma unroll
                for (int bj = 0; bj < 2; ++bj) {
                    const int row = rowb + ai * 128 + m * 16; const size_t off = (size_t)row * 1024 + c8 + bj * 128;
                    float gv[8], v[8]; ldbf8(gate + off, gv); acc8(acc, ai, bj, m, v);
                    u32x4* slot = pt + ((ai * 4 + m) * 2 + bj) * 512;
                    if (u.sel == 0) {
#pragma unroll
                        for (int j = 0; j < 8; ++j) v[j] *= gv[j];
                        u32x4 w; w.x = cvt_pk_bf16(v[0], v[1]); w.y = cvt_pk_bf16(v[2], v[3]); w.z = cvt_pk_bf16(v[4], v[5]); w.w = cvt_pk_bf16(v[6], v[7]); *slot = w;
                    } else {
                        float pv[8]; ldbf8((const bf16_t*)slot, pv);
#pragma unroll
                        for (int j = 0; j < 8; ++j) v[j] = pv[j] + v[j] * gv[j];
                        st8(mg + off, v);
                    }
                }
    }
};

struct Epi3 {
    Ptrs P;
    __device__ __forceinline__ void operator()(const acc_t& acc, const pg8::Unit& u, int wr, int wc, int fr, int fq) const {
        unsigned char* ws = P.ws; const int rowb = u.pm * 256 + wr * 64 + fr, c8 = u.pn * 256 + wc * 32 + fq * 8;
        bf16_t* x1b = (bf16_t*)(ws + WS_X1B); float* rs = (float*)(ws + WS_RS);
#pragma unroll
        for (int ai = 0; ai < 2; ++ai)
#pragma unroll
            for (int m = 0; m < 4; ++m) {
                const int row = rowb + ai * 128 + m * 16; float ss = 0.f;
#pragma unroll
                for (int bj = 0; bj < 2; ++bj) {
                    const size_t off = (size_t)row * 1024 + c8 + bj * 128; float xv[8], v[8]; ld8(P.x + off, xv); acc8(acc, ai, bj, m, v);
#pragma unroll
                    for (int j = 0; j < 8; ++j) { v[j] += xv[j]; ss += v[j] * v[j]; }
                    *(f32x4*)(P.out + off) = (f32x4){v[0], v[1], v[2], v[3]}; *(f32x4*)(P.out + off + 4) = (f32x4){v[4], v[5], v[6], v[7]};
                    st8(x1b + off, v);
                }
                ss += __shfl_xor(ss, 16); ss += __shfl_xor(ss, 32);
                if (fq == 0) rs[(size_t)row * 16 + u.pn * 4 + wc] = ss;
            }
    }
};

struct Epi4 {
    Ptrs P;
    __device__ __forceinline__ void operator()(const acc_t& acc, const pg8::Unit& u, int wr, int wc, int fr, int fq) const {
        unsigned char* ws = P.ws; const int rowb = u.pm * 256 + wr * 64 + fr, c8 = u.pn * 128 + wc * 32 + fq * 8;
        bf16_t* actp = (bf16_t*)(ws + WS_ACT); const float* rs = (const float*)(ws + WS_RS);
#pragma unroll
        for (int ai = 0; ai < 2; ++ai)
#pragma unroll
            for (int m = 0; m < 4; ++m) {
                const int row = rowb + ai * 128 + m * 16;
                const f32x4 r0 = *(const f32x4*)(rs + (size_t)row * 16 + 4 * fq);
                float ssum = (r0[0] + r0[1]) + (r0[2] + r0[3]); ssum += __shfl_xor(ssum, 16); ssum += __shfl_xor(ssum, 32);
                const float rn = rsqrtf_(ssum * (1.0f / 1024.0f) + EPS);
                float gv[8], uv[8], o[8]; acc8(acc, ai, 0, m, gv); acc8(acc, ai, 1, m, uv);
#pragma unroll
                for (int j = 0; j < 8; ++j) { const float gg = gv[j] * rn, uu = uv[j] * rn; o[j] = gg * sigmoidf_(gg) * uu; }
                st8(actp + (size_t)row * DFF + c8, o);
            }
    }
};

template <bool DRY> struct Epi5 {
    Ptrs P;
    __device__ __forceinline__ void operator()(const acc_t& acc, const pg8::Unit& u, int wr, int wc, int fr, int fq) const {
        const int rowb = u.pm * 256 + wr * 64 + fr, c8 = u.pn * 256 + wc * 32 + fq * 8;
#pragma unroll
        for (int ai = 0; ai < 2; ++ai)
#pragma unroll
            for (int m = 0; m < 4; ++m)
#pragma unroll
                for (int bj = 0; bj < 2; ++bj) {
                    const size_t off = (size_t)(rowb + ai * 128 + m * 16) * 1024 + c8 + bj * 128; float xv[8], v[8]; ld8(P.out + off, xv); acc8(acc, ai, bj, m, v);
                    if (DRY) {
#pragma unroll
                        for (int j = 0; j < 8; ++j) v[j] *= P.fz; }
                    *(f32x4*)(P.out + off) = (f32x4){v[0] + xv[0], v[1] + xv[1], v[2] + xv[2], v[3] + xv[3]}; *(f32x4*)(P.out + off + 4) = (f32x4){v[4] + xv[4], v[5] + xv[5], v[6] + xv[6], v[7] + xv[7]};
                }
    }
};

constexpr int NWAVES = 8;
constexpr int RING_OFF = 0, RING_BYTES = 131072;
constexpr int SCR_BYTES = 139264;
constexpr int LDSCTL_OFF = SCR_BYTES, MISC_OFF = LDSCTL_OFF + 320;
constexpr int LDS_BYTES = 147456;
#define RLX_AGENT __ATOMIC_RELAXED, __HIP_MEMORY_SCOPE_AGENT
#define LDS_WAIT() asm volatile("s_waitcnt lgkmcnt(0)" ::: "memory")
#define VM_WAIT() asm volatile("s_waitcnt vmcnt(0)" ::: "memory")

#define XB_TMO      128
#define XB_XCNT(j)  (256  + 64 * (j))
#define XB_XSUB(j)  (1280 + 64 * (j))
#define XB_XGEN(j)  (2304 + 64 * (j))
#define XB_TOP      3328
#define XB_TOPGEN   3392
#define XCD_BAR_WORDS 3456
#define XB_SPIN_CAP (1u << 22)
__device__ __forceinline__ unsigned xb_ld(unsigned* p)              { return __hip_atomic_load(p, __ATOMIC_RELAXED, __HIP_MEMORY_SCOPE_AGENT); }
__device__ __forceinline__ unsigned xb_add(unsigned* p, unsigned v) { return __hip_atomic_fetch_add(p, v, __ATOMIC_RELAXED, __HIP_MEMORY_SCOPE_AGENT); }
__device__ __forceinline__ unsigned xb_xcc_id() { return (unsigned)__builtin_amdgcn_s_getreg((3 << 11) | 20) & 0xFu; }
#define XB_SPIN(cond, bar) do { unsigned _sp = 0; while (cond) { __builtin_amdgcn_s_sleep(1); \
    if ((++_sp & 255u) == 0u) { if (xb_ld(&(bar)[XB_TMO])) break; if (_sp > XB_SPIN_CAP) { atomicAdd(&(bar)[XB_TMO], 1u); break; } } } } while (0)
struct XcdBarrier { unsigned* bar; unsigned x; volatile LAS unsigned* st; };
__device__ __forceinline__ XcdBarrier xcd_barrier_post(unsigned* bar, volatile LAS unsigned* st) {
    XcdBarrier b; b.bar = bar; b.x = xb_xcc_id(); b.st = st;
    if (threadIdx.x == 0) (void)xb_add(&bar[XB_XCNT(b.x)], 1u);
    return b;
}
__device__ __forceinline__ void xcd_barrier_complete(unsigned* bar, unsigned x, unsigned& nloc, unsigned& nx) {
    const unsigned G = gridDim.x * gridDim.y * gridDim.z;
    unsigned sum, cnt, mine, sp = 0u;
    for (;;) {
        sum = 0u; cnt = 0u; mine = 0u;
#pragma unroll
        for (unsigned j = 0; j < 16; ++j) { const unsigned c = xb_ld(&bar[XB_XCNT(j)]); sum += c; cnt += (c > 0u) ? 1u : 0u; mine = (j == x) ? c : mine; }
        if (sum == G) break;
        __builtin_amdgcn_s_sleep(1);
        if ((++sp & 255u) == 0u) { if (xb_ld(&bar[XB_TMO])) break; if (sp > XB_SPIN_CAP) { atomicAdd(&bar[XB_TMO], 1u); break; } }
    }
    nloc = mine > 0u ? mine : 1u; nx = cnt > 0u ? cnt : 1u;
}
__device__ __forceinline__ void xcd_barrier(const XcdBarrier& b) {
    asm volatile("s_waitcnt vmcnt(0)" ::: "memory");
    __syncthreads();
    if (threadIdx.x == 0) {
        unsigned* bar = b.bar;
        __builtin_amdgcn_s_waitcnt(0);
        unsigned nloc = b.st[0], nx = b.st[1];
        if (nloc == 0u) { xcd_barrier_complete(bar, b.x, nloc, nx); b.st[0] = nloc; b.st[1] = nx; }
        const unsigned old = xb_add(&bar[XB_XSUB(b.x)], 1u);
        const unsigned gen = old / nloc;
        if (old + 1u == (gen + 1u) * nloc) {
            __builtin_amdgcn_fence(__ATOMIC_RELEASE, "agent");
            asm volatile("s_waitcnt vmcnt(0)" ::: "memory");
            const unsigned og = xb_add(&bar[XB_TOP], 1u);
            const unsigned tg = og / nx;
            if (og + 1u == (tg + 1u) * nx) xb_add(&bar[XB_TOPGEN], 1u);
            else XB_SPIN(xb_ld(&bar[XB_TOPGEN]) == tg, bar);
            __builtin_amdgcn_fence(__ATOMIC_ACQUIRE, "agent");
            xb_add(&bar[XB_XGEN(b.x)], 1u);
            asm volatile("s_waitcnt vmcnt(0)" ::: "memory");
        } else {
            XB_SPIN(xb_ld(&bar[XB_XGEN(b.x)]) == gen, bar);
            __builtin_amdgcn_fence(__ATOMIC_ACQUIRE, "agent");
            asm volatile("s_waitcnt vmcnt(0)" ::: "memory");
        }
    }
    __syncthreads();
}

__device__ __forceinline__ int slot_col(int gm, int srow, int& which) {
    const int pn = srow >> 8, s = srow & 255, bj = s >> 7, wc = (s >> 5) & 3, n = (s >> 4) & 1, fq = (s >> 2) & 3, j = s & 3;
    which = 0;
    if (gm == 0) {
        if (pn < 4) return pn * 256 + (wc >> 1) * 128 + bj * 64 + (wc & 1) * 32 + fq * 8 + n * 4 + j;
        if (pn >= 12 && pn < 16) return pn * 256 + wc * 64 + bj * 32 + fq * 8 + n * 4 + j;
        if (pn == 16 && bj == 0) return 4096 + (wc >> 1) * 64 + n * 32 + (wc & 1) * 16 + fq * 4 + j;
    }
    if (gm == 4) { which = bj; return pn * 128 + wc * 32 + fq * 8 + n * 4 + j; }
    return pn * 256 + bj * 128 + wc * 32 + fq * 8 + n * 4 + j;
}
__device__ __forceinline__ void p0_transpose_item(const float* W0, const float* W1, int K, int N, const float* kscale, bf16_t* WT, int gm, LAS float* scr, int item, int lane) {
    const int nblk_k = K / 64, sb = item / nblk_k, kb = item % nblk_k, k0 = 64 * kb, s0 = 32 * sb;
    int which; const int col = slot_col(gm, s0 + (lane & 31), which); const float* W = which ? W1 : W0;
#pragma unroll 8
    for (int i = 0; i < 32; ++i) { const int kk = 2 * i + (lane >> 5); float v = W[(size_t)(k0 + kk) * N + col]; if (kscale) v *= kscale[k0 + kk]; scr[kk * 33 + (lane & 31)] = v; }
    LDS_WAIT(); asm volatile("" ::: "memory");
    const int c = lane & 7;
#pragma unroll
    for (int j = 0; j < 4; ++j) { const int n = (lane >> 3) + 8 * j; const LAS float* s = scr + (8 * c) * 33 + n;
        u32x4 o; o.x = pk2(s[0 * 33], s[1 * 33]); o.y = pk2(s[2 * 33], s[3 * 33]); o.z = pk2(s[4 * 33], s[5 * 33]); o.w = pk2(s[6 * 33], s[7 * 33]);
        *(u32x4*)(WT + (size_t)(s0 + n) * K + k0 + 8 * c) = o; }
    LDS_WAIT(); asm volatile("" ::: "memory");
}
__device__ __forceinline__ void sincos_d(double a, float& s, float& c) {
    const double k = rint(a * 0.63661977236758134308);
    double r = fma(-k, 1.57079632679489655800e+00, a); r = fma(-k, 6.12323399573676603587e-17, r);
    const double r2 = r * r;
    double sp = 1.0 / 6227020800.0; sp = fma(sp, r2, -1.0 / 39916800.0); sp = fma(sp, r2, 1.0 / 362880.0); sp = fma(sp, r2, -1.0 / 5040.0); sp = fma(sp, r2, 1.0 / 120.0); sp = fma(sp, r2, -1.0 / 6.0); sp = fma(sp * r2, r, r);
    double cp = 1.0 / 87178291200.0; cp = fma(cp, r2, -1.0 / 479001600.0); cp = fma(cp, r2, 1.0 / 3628800.0); cp = fma(cp, r2, -1.0 / 40320.0); cp = fma(cp, r2, 1.0 / 720.0); cp = fma(cp, r2, -1.0 / 24.0); cp = fma(cp, r2, 0.5); cp = fma(-cp, r2, 1.0);
    const int q = ((int)k) & 3;
    const double ss = (q & 1) ? cp : sp, cc = (q & 1) ? sp : cp;
    s = (float)((q & 2) ? -ss : ss); c = (float)(((q + 1) & 2) ? -cc : cc);
}

struct Frame {
    LAS unsigned char* lds; volatile LAS unsigned* MISC; gu32* ctl;
    int tid, lane, wave, vcu, G;
};

__device__ __forceinline__ void p0_prologue(const Frame& F, const float* const* in, const Ptrs& P) {
    unsigned char* ws = P.ws;
    LAS float* scr = (LAS float*)(F.lds + RING_OFF + F.wave * 16384);
    const int gw = F.vcu * NWAVES + F.wave, NGW = F.G * NWAVES;
    constexpr int I0 = (DIN / 32) * (D / 64), I1 = (D / 32) * (D / 64), I4 = (NGU / 32) * (D / 64), I5 = (D / 32) * (DFF / 64);
    constexpr int NITEMS = I0 + 3 * I1 + I4 + I5;
    for (int it = gw; it < NITEMS; it += NGW) {
        int r = it;
        if (r < I0) { p0_transpose_item(in[2], nullptr, D, DIN, nullptr, (bf16_t*)(ws + WS_W1), 0, scr, r, F.lane); continue; } r -= I0;
        if (r < I1) { p0_transpose_item(in[5], nullptr, D, D, nullptr, (bf16_t*)(ws + WS_WR), 1, scr, r, F.lane); continue; } r -= I1;
        if (r < I1) { p0_transpose_item(in[7], nullptr, D, D, nullptr, (bf16_t*)(ws + WS_WA), 2, scr, r, F.lane); continue; } r -= I1;
        if (r < I1) { p0_transpose_item(in[8], nullptr, D, D, nullptr, (bf16_t*)(ws + WS_WO), 3, scr, r, F.lane); continue; } r -= I1;
        if (r < I4) { p0_transpose_item(in[10], in[11], D, DFF, in[9], (bf16_t*)(ws + WS_WGU), 4, scr, r, F.lane); continue; } r -= I4;
        p0_transpose_item(in[12], nullptr, DFF, D, nullptr, (bf16_t*)(ws + WS_WD), 5, scr, r, F.lane);
    }
    {
        float* cosR = (float*)(ws + WS_COSR); float* sinR = (float*)(ws + WS_SINR); float* cosA = (float*)(ws + WS_COSA); float* sinA = (float*)(ws + WS_SINA);
        const int gt = F.vcu * (NWAVES * 64) + F.tid, NGT = F.G * NWAVES * 64;
        for (int e = gt; e < SEQ * 64; e += NGT) {
            const int pos = e >> 6, i = e & 63;
            double inv = 1.0; for (int k = 0; k < i; ++k) inv *= 0.8659643233600653;
            float s, c; sincos_d((double)pos * inv, s, c);
            cosR[e] = c; sinR[e] = s;
            if ((i & 1) == 0) { cosA[pos * 32 + (i >> 1)] = c; sinA[pos * 32 + (i >> 1)] = s; }
        }
    }
    {
        const float* g1 = in[1]; bf16_t* H1 = (bf16_t*)P.out;
        f32x4 gv[4];
#pragma unroll
        for (int j = 0; j < 4; ++j) gv[j] = *((const f32x4*)g1 + F.lane + 64 * j);
        for (int m = gw; m < M; m += NGW) {
            const f32x4* xr = (const f32x4*)(P.x + (size_t)m * D) + F.lane;
            f32x4 v[4]; float s = 0.f;
#pragma unroll
            for (int j = 0; j < 4; ++j) { v[j] = xr[64 * j]; s += (v[j].x * v[j].x + v[j].y * v[j].y) + (v[j].z * v[j].z + v[j].w * v[j].w); }
            const float rn = rsqrtf_(wave_sum(s) * (1.0f / D) + EPS);
            unsigned long long* o8 = (unsigned long long*)(H1 + (size_t)m * D) + F.lane;
#pragma unroll
            for (int j = 0; j < 4; ++j) { const f32x4 y = v[j] * rn * gv[j]; o8[64 * j] = (unsigned long long)cvt_pk_bf16(y.x, y.y) | ((unsigned long long)cvt_pk_bf16(y.z, y.w) << 32); }
        }
    }
}

__device__ __forceinline__ void p2_attention_simple(const Frame& F, const Ptrs& P) {
    unsigned char* ws = P.ws;
    bf16_t* AQ = (bf16_t*)(ws + WS_AQ); const bf16_t* AK = (const bf16_t*)(ws + WS_AK); const bf16_t* AV = (const bf16_t*)(ws + WS_AV);
    const int gw = F.vcu * NWAVES + F.wave, NGW = F.G * NWAVES, lane = F.lane;
    for (int task = gw; task < M * AH; task += NGW) {
        const int row = task >> 4, hd = task & 15, kvh = hd >> 3, t = row & (SEQ - 1);
        float q[64];
        { const u32x4* qp = (const u32x4*)(AQ + (size_t)row * 1024 + hd * 64);
#pragma unroll
          for (int i = 0; i < 8; ++i) { const u32x4 w = qp[i]; q[8 * i] = bf_lo(w.x); q[8 * i + 1] = bf_hi(w.x); q[8 * i + 2] = bf_lo(w.y); q[8 * i + 3] = bf_hi(w.y); q[8 * i + 4] = bf_lo(w.z); q[8 * i + 5] = bf_hi(w.z); q[8 * i + 6] = bf_lo(w.w); q[8 * i + 7] = bf_hi(w.w); } }
        float sc[2];
#pragma unroll
        for (int h = 0; h < 2; ++h) {
            const int kk = lane + 64 * h; float s = -1e30f;
            if (kk <= t) {
                const u32x4* kp = (const u32x4*)(AK + (size_t)(row - kk) * 128 + kvh * 64); s = 0.f;
#pragma unroll
                for (int i = 0; i < 8; ++i) { const u32x4 w = kp[i]; s += q[8 * i] * bf_lo(w.x) + q[8 * i + 1] * bf_hi(w.x) + q[8 * i + 2] * bf_lo(w.y) + q[8 * i + 3] * bf_hi(w.y) + q[8 * i + 4] * bf_lo(w.z) + q[8 * i + 5] * bf_hi(w.z) + q[8 * i + 6] * bf_lo(w.w) + q[8 * i + 7] * bf_hi(w.w); }
            }
            sc[h] = s;
        }
        const float sink = P.sinks[hd] * 1.4426950408889634f;
        const float mx = fmaxf(wave_max(fmaxf(sc[0], sc[1])), sink);
        const float e0 = exp2f(sc[0] - mx), e1 = exp2f(sc[1] - mx);
        const float den = wave_sum(e0 + e1) + exp2f(sink - mx);
        float o = 0.f;
        const int nk = t + 1 < 128 ? t + 1 : 128;
        for (int kk = 0; kk < nk; ++kk) {
            const float p = __shfl(kk < 64 ? e0 : e1, kk & 63);
            o += p * bf2f(AV[(size_t)(row - kk) * 128 + kvh * 64 + lane]);
        }
        o /= den;
        AQ[(size_t)row * 1024 + hd * 64 + lane] = (bf16_t)f2bf(o);
    }
}

__device__ __forceinline__ void p2_retkv_simple(const Frame& F, const Ptrs& P) {
    unsigned char* ws = P.ws;
    const bf16_t* RK = (const bf16_t*)(ws + WS_RK); const bf16_t* RV = (const bf16_t*)(ws + WS_RV); bf16_t* KV = (bf16_t*)P.out;
    LAS float* Kl = (LAS float*)(F.lds + RING_OFF);
    const int tid = F.tid;
    for (int task = blockIdx.x; task < NB * RH * NCH; task += F.G) {
        const int n = task & (NCH - 1), h = (task >> 6) & 3, b = task >> 8; const int r0 = b * SEQ + n * RC;
        const float lg = ret_log2_gamma(h);
        __syncthreads();
        for (int i = tid; i < 128 * 128; i += 512) { const int s = i >> 7, d = i & 127; Kl[i] = bf2f(RK[(size_t)(r0 + s) * 512 + h * 128 + d]) * exp2f(lg * (float)(127 - s)); }
        __syncthreads();
        const int e = tid & 255, dh = tid >> 8;
        float acc[64];
#pragma unroll
        for (int i = 0; i < 64; ++i) acc[i] = 0.f;
        for (int s = 0; s < 128; ++s) {
            const float v = bf2f(RV[(size_t)(r0 + s) * 1024 + h * 256 + e]);
            const LAS f32x4* kr = (const LAS f32x4*)(Kl + s * 128 + dh * 64);
#pragma unroll
            for (int i = 0; i < 16; ++i) { const f32x4 k4 = kr[i]; acc[4 * i] += k4[0] * v; acc[4 * i + 1] += k4[1] * v; acc[4 * i + 2] += k4[2] * v; acc[4 * i + 3] += k4[3] * v; }
        }
        bf16_t* op = KV + ((size_t)task * 256 + e) * 128 + dh * 64;
#pragma unroll
        for (int i = 0; i < 8; ++i) { u32x4 w; w.x = cvt_pk_bf16(acc[8 * i], acc[8 * i + 1]); w.y = cvt_pk_bf16(acc[8 * i + 2], acc[8 * i + 3]); w.z = cvt_pk_bf16(acc[8 * i + 4], acc[8 * i + 5]); w.w = cvt_pk_bf16(acc[8 * i + 6], acc[8 * i + 7]); *(u32x4*)(op + 8 * i) = w; }
    }
}


typedef float f32x16 __attribute__((ext_vector_type(16)));
typedef short s16x4 __attribute__((ext_vector_type(4)));
typedef __bf16 bf16x2_t __attribute__((ext_vector_type(2)));
#define MFMA32(a, b, c) __builtin_amdgcn_mfma_f32_32x32x16_bf16((a), (b), (c), 0, 0, 0)
__device__ __forceinline__ int crow(int r, int h) { return (r & 3) + 8 * (r >> 2) + 4 * h; }
__device__ __forceinline__ unsigned cvtpk(float lo, float hi) { f32x2 v = {lo, hi}; bf16x2_t b = __builtin_convertvector(v, bf16x2_t); return __builtin_bit_cast(unsigned, b); }
__device__ __forceinline__ bf16x8 pack8(const f32x16& x, int s) { u32x4 p; p.x = cvtpk(x[8 * s], x[8 * s + 1]); p.y = cvtpk(x[8 * s + 2], x[8 * s + 3]); p.z = cvtpk(x[8 * s + 4], x[8 * s + 5]); p.w = cvtpk(x[8 * s + 6], x[8 * s + 7]); return __builtin_bit_cast(bf16x8, p); }
__device__ __forceinline__ s16x4 tr_rd(const LAS unsigned char* p) { return __builtin_bit_cast(s16x4, __builtin_amdgcn_ds_read_tr16_b64_v4i16((LAS s16x4*)p)); }
__device__ __forceinline__ bf16x8 tr_frag(const LAS unsigned char* trbase, int pitch, int k_lo, int k_hi, int col0) {
    const s16x4 lo = tr_rd(trbase + k_lo * pitch + col0 * 2), hi = tr_rd(trbase + k_hi * pitch + col0 * 2);
    return (bf16x8){lo[0], lo[1], lo[2], lo[3], hi[0], hi[1], hi[2], hi[3]};
}

constexpr int ATT_KP = 144, ATT_VP = 192, ATT_SP = 144;
constexpr int ATT_K_OFF = 0, ATT_V_OFF = 256 * ATT_KP, ATT_S_OFF = ATT_V_OFF + 256 * ATT_VP;
__device__ __forceinline__ void p2_attention(const Frame& F, const Ptrs& P, bf16_t* AY) {
    unsigned char* ws = P.ws;
    const bf16_t* AQ = (const bf16_t*)(ws + WS_AQ); const bf16_t* AK = (const bf16_t*)(ws + WS_AK); const bf16_t* AV = (const bf16_t*)(ws + WS_AV);
    const int tid = F.tid, lane = F.lane, wave = F.wave, r32 = lane & 31, hh = lane >> 5;
    LAS unsigned char* Kl = F.lds + ATT_K_OFF; LAS unsigned char* Vl = F.lds + ATT_V_OFF; LAS unsigned char* Sl = F.lds + ATT_S_OFF + wave * (32 * ATT_SP);
    const LAS unsigned char* vtr = Vl + ((lane & 15) >> 2) * ATT_VP + (16 * ((lane >> 4) & 1) + 4 * (lane & 3)) * 2;
    for (int unit = blockIdx.x; unit < NB * (SEQ / 128) * AKV; unit += F.G) {
        const int kvh = unit & 1, nb = (unit >> 1) & 63, b = unit >> 7; const int row0 = b * SEQ + nb * 128;
        __syncthreads();
        for (int i = tid; i < 256 * 8; i += 512) {
            const int key = i >> 3, ch = i & 7; if (nb == 0 && key < 128) continue;
            const size_t g = (size_t)(row0 - 128 + key) * 128 + kvh * 64 + ch * 8;
            *(LAS u32x4*)(Kl + key * ATT_KP + ch * 16) = *(const u32x4*)(AK + g);
            *(LAS u32x4*)(Vl + key * ATT_VP + ch * 16) = *(const u32x4*)(AV + g);
        }
        __syncthreads();
        const int head = kvh * 8 + wave;
        const float sink2 = P.sinks[head] * 1.4426950408889634f;
#pragma unroll 1
        for (int qt = 0; qt < 4; ++qt) {
            bf16x8 qf[4];
            { const bf16_t* qp = AQ + (size_t)(row0 + 32 * qt + r32) * 1024 + head * 64 + 8 * hh;
#pragma unroll
              for (int ks = 0; ks < 4; ++ks) qf[ks] = *(const bf16x8*)(qp + 16 * ks); }
            f32x16 sc[5];
#pragma unroll
            for (int t = 0; t < 5; ++t) {
                const int kt = qt + t;
                if (nb == 0 && kt < 4) {
#pragma unroll
                    for (int r = 0; r < 16; ++r) sc[t][r] = -1e30f;
                } else {
                    const LAS unsigned char* kp = Kl + (32 * kt + r32) * ATT_KP + 16 * hh;
                    f32x16 a;
#pragma unroll
                    for (int r = 0; r < 16; ++r) a[r] = 0.f;
#pragma unroll
                    for (int ks = 0; ks < 4; ++ks) a = MFMA32(*(const LAS bf16x8*)(kp + 32 * ks), qf[ks], a);
                    if (t == 0) {
#pragma unroll
                        for (int r = 0; r < 16; ++r) if (crow(r, hh) <= r32) a[r] = -1e30f;
                    }
                    if (t == 4) {
#pragma unroll
                        for (int r = 0; r < 16; ++r) if (crow(r, hh) > r32) a[r] = -1e30f;
                    }
                    sc[t] = a;
                }
            }
            float m = sink2;
#pragma unroll
            for (int t = 0; t < 5; ++t)
#pragma unroll
                for (int r = 0; r < 16; ++r) m = fmaxf(m, sc[t][r]);
            m = fmaxf(m, __shfl_xor(m, 32));
            float l = 0.f;
#pragma unroll
            for (int t = 0; t < 5; ++t)
#pragma unroll
                for (int r = 0; r < 16; ++r) { const float p = exp2f(sc[t][r] - m); sc[t][r] = p; l += p; }
            l += __shfl_xor(l, 32);
            l += exp2f(sink2 - m);
            f32x16 o[2];
#pragma unroll
            for (int r = 0; r < 16; ++r) { o[0][r] = 0.f; o[1][r] = 0.f; }
#pragma unroll
            for (int t = 0; t < 5; ++t) {
                const int kt = qt + t;
                if (!(nb == 0 && kt < 4)) {
#pragma unroll
                    for (int s2 = 0; s2 < 2; ++s2) {
                        const bf16x8 pb = pack8(sc[t], s2);
                        const int k0 = 32 * kt + 16 * s2 + 4 * hh;
#pragma unroll
                        for (int dt = 0; dt < 2; ++dt) o[dt] = MFMA32(tr_frag(vtr, ATT_VP, k0, k0 + 8, 32 * dt), pb, o[dt]);
                    }
                }
            }
            const float rl = 1.0f / l;
#pragma unroll
            for (int dt = 0; dt < 2; ++dt)
#pragma unroll
                for (int g = 0; g < 4; ++g) {
                    u32x2 w; w.x = cvtpk(o[dt][4 * g] * rl, o[dt][4 * g + 1] * rl); w.y = cvtpk(o[dt][4 * g + 2] * rl, o[dt][4 * g + 3] * rl);
                    *(LAS u32x2*)(Sl + r32 * ATT_SP + (32 * dt + 8 * g + 4 * hh) * 2) = w;
                }
#pragma unroll
            for (int i = 0; i < 4; ++i) {
                const int rr = i * 8 + (lane >> 3), ch = lane & 7;
                const u32x4 v = *(const LAS u32x4*)(Sl + rr * ATT_SP + ch * 16);
                *(u32x4*)(AY + (size_t)(row0 + 32 * qt + rr) * 1024 + head * 64 + ch * 8) = v;
            }
        }
    }
}

constexpr int RKV_KP = 320, RKV_VP = 576;
constexpr int RKV_K_OFF = 0, RKV_V_OFF = 128 * RKV_KP;
__device__ __forceinline__ void p2_retkv(const Frame& F, const Ptrs& P) {
    unsigned char* ws = P.ws;
    const bf16_t* RK = (const bf16_t*)(ws + WS_RK); const bf16_t* RV = (const bf16_t*)(ws + WS_RV); bf16_t* KV = (bf16_t*)P.out;
    const int tid = F.tid, lane = F.lane, wave = F.wave, r32 = lane & 31, hh = lane >> 5;
    LAS unsigned char* Kl = F.lds + RKV_K_OFF; LAS unsigned char* Vl = F.lds + RKV_V_OFF;
    const int troff = (16 * ((lane >> 4) & 1) + 4 * (lane & 3)) * 2, trq = (lane & 15) >> 2;
    const LAS unsigned char* ktr = Kl + trq * RKV_KP + troff; const LAS unsigned char* vtr = Vl + trq * RKV_VP + troff;
    for (int task = blockIdx.x; task < NB * RH * NCH; task += F.G) {
        const int n = task & (NCH - 1), h = (task >> 6) & 3, b = task >> 8; const int r0 = b * SEQ + n * RC;
        const float lg = ret_log2_gamma(h);
        __syncthreads();
        for (int i = tid; i < 128 * 16; i += 512) {
            const int s = i >> 4, ch = i & 15; float v[8]; ldbf8(RK + (size_t)(r0 + s) * 512 + h * 128 + ch * 8, v);
            const float f = exp2f(lg * (float)(127 - s));
            u32x4 w; w.x = cvtpk(v[0] * f, v[1] * f); w.y = cvtpk(v[2] * f, v[3] * f); w.z = cvtpk(v[4] * f, v[5] * f); w.w = cvtpk(v[6] * f, v[7] * f);
            *(LAS u32x4*)(Kl + s * RKV_KP + ch * 16) = w;
        }
        for (int i = tid; i < 128 * 32; i += 512) { const int s = i >> 5, ch = i & 31; *(LAS u32x4*)(Vl + s * RKV_VP + ch * 16) = *(const u32x4*)(RV + (size_t)(r0 + s) * 1024 + h * 256 + ch * 8); }
        __syncthreads();
        f32x16 acc[4];
#pragma unroll
        for (int dt = 0; dt < 4; ++dt)
#pragma unroll
            for (int r = 0; r < 16; ++r) acc[dt][r] = 0.f;
#pragma unroll 2
        for (int ks = 0; ks < 8; ++ks) {
            const int k0 = 16 * ks + 8 * hh;
            const bf16x8 vb = tr_frag(vtr, RKV_VP, k0, k0 + 4, 32 * wave);
#pragma unroll
            for (int dt = 0; dt < 4; ++dt) acc[dt] = MFMA32(tr_frag(ktr, RKV_KP, k0, k0 + 4, 32 * dt), vb, acc[dt]);
        }
        bf16_t* op = KV + ((size_t)task * 256 + 32 * wave + r32) * 128;
#pragma unroll
        for (int dt = 0; dt < 4; ++dt)
#pragma unroll
            for (int g = 0; g < 4; ++g) {
                u32x2 w; w.x = cvtpk(acc[dt][4 * g], acc[dt][4 * g + 1]); w.y = cvtpk(acc[dt][4 * g + 2], acc[dt][4 * g + 3]);
                *(u32x2*)(op + 32 * dt + 8 * g + 4 * hh) = w;
            }
    }
}

__device__ __forceinline__ void p3_scan(const Frame& F, const Ptrs& P) {
    const bf16_t* KV = (const bf16_t*)P.out; bf16_t* S = (bf16_t*)((unsigned char*)P.out + 64 * MiB);
    const int gt = F.vcu * (NWAVES * 64) + F.tid, NGT = F.G * NWAVES * 64;
    for (int it = gt; it < NB * RH * (RDV * RDK / 8); it += NGT) {
        const int bh = it >> 12, el = (it & 4095) * 8; const int h = bh & 3;
        const float cd = exp2f(ret_log2_gamma(h) * 128.0f);
        float st[8];
#pragma unroll
        for (int j = 0; j < 8; ++j) st[j] = 0.f;
        const size_t base = (size_t)bh * NCH * 32768 + el;
#pragma unroll 4
        for (int n = 0; n < NCH; ++n) {
            float kv[8]; ldbf8(KV + base + (size_t)n * 32768, kv);
            st8(S + base + (size_t)n * 32768, st);
#pragma unroll
            for (int j = 0; j < 8; ++j) st[j] = st[j] * cd + kv[j];
        }
    }
}

__device__ __forceinline__ void p4_retout_simple(const Frame& F, const Ptrs& P) {
    unsigned char* ws = P.ws;
    const bf16_t* RQ = (const bf16_t*)(ws + WS_RQ); const bf16_t* RK = (const bf16_t*)(ws + WS_RK); const bf16_t* RV = (const bf16_t*)(ws + WS_RV); bf16_t* RG = (bf16_t*)(ws + WS_RG);
    const bf16_t* S = (const bf16_t*)((unsigned char*)P.out + 64 * MiB);
    LAS unsigned* Ql = (LAS unsigned*)(F.lds + RING_OFF);
    LAS unsigned* Kl = (LAS unsigned*)(F.lds + RING_OFF + 32768);
    LAS float* Pl = (LAS float*)(F.lds + RING_OFF + 66048);
    const int tid = F.tid, lane = F.lane, wave = F.wave;
    for (int task = blockIdx.x; task < NB * RH * NCH; task += F.G) {
        const int n = task & (NCH - 1), h = (task >> 6) & 3, b = task >> 8; const int r0 = b * SEQ + n * RC;
        const float lg = ret_log2_gamma(h);
        __syncthreads();
        for (int i = tid; i < 128 * 64; i += 512) { const int s = i >> 6, d2 = i & 63;
            Ql[s * 64 + d2] = *(const unsigned*)(RQ + (size_t)(r0 + s) * 512 + h * 128 + 2 * d2);
            Kl[s * 65 + d2] = *(const unsigned*)(RK + (size_t)(r0 + s) * 512 + h * 128 + 2 * d2); }
        __syncthreads();
        {
            const int s = tid & 127, cq = tid >> 7; float a[32];
#pragma unroll
            for (int i = 0; i < 32; ++i) a[i] = 0.f;
            for (int d2 = 0; d2 < 64; ++d2) {
                const unsigned kw = Kl[s * 65 + d2]; const float k0 = bf_lo(kw), k1 = bf_hi(kw);
#pragma unroll
                for (int i = 0; i < 32; ++i) { const unsigned qw = Ql[(cq * 32 + i) * 64 + d2]; a[i] += bf_lo(qw) * k0 + bf_hi(qw) * k1; }
            }
#pragma unroll
            for (int i = 0; i < 32; ++i) { const int c = cq * 32 + i; Pl[c * 128 + s] = c >= s ? a[i] * exp2f(lg * (float)(c - s)) : 0.f; }
        }
        __syncthreads();
        const int e = tid & 255, ch = tid >> 8;
        LAS float* red = (LAS float*)(F.lds + RING_OFF + 131584);
        const float gg = P.rg_g[h * 256 + e];
#pragma unroll 1
        for (int pass = 0; pass < 2; ++pass) {
            const int cb = pass * 64 + ch * 32;
            float acc[32], acc2[32];
#pragma unroll
            for (int i = 0; i < 32; ++i) { acc[i] = 0.f; acc2[i] = 0.f; }
            for (int s = 0; s < 128; ++s) {
                const float v = bf2f(RV[(size_t)(r0 + s) * 1024 + h * 256 + e]);
#pragma unroll
                for (int i = 0; i < 32; ++i) acc[i] += Pl[(cb + i) * 128 + s] * v;
            }
            const bf16_t* sp = S + ((size_t)task * 256 + e) * 128;
            for (int d2 = 0; d2 < 64; ++d2) {
                const unsigned sw = *(const unsigned*)(sp + 2 * d2); const float s0 = bf_lo(sw), s1 = bf_hi(sw);
#pragma unroll
                for (int i = 0; i < 32; ++i) { const unsigned qw = Ql[(cb + i) * 64 + d2]; acc2[i] += bf_lo(qw) * s0 + bf_hi(qw) * s1; }
            }
#pragma unroll
            for (int i = 0; i < 32; ++i) {
                acc[i] += exp2f(lg * (float)(cb + i + 1)) * acc2[i];
                const float s1 = wave_sum(acc[i]), s2 = wave_sum(acc[i] * acc[i]);
                if (lane == 0) { red[((cb + i) * 4 + (wave & 3)) * 2] = s1; red[((cb + i) * 4 + (wave & 3)) * 2 + 1] = s2; }
            }
            __syncthreads();
#pragma unroll
            for (int i = 0; i < 32; ++i) {
                const LAS f32x4* rp = (const LAS f32x4*)(red + (cb + i) * 8); const f32x4 ra = rp[0], rb = rp[1];
                const float mean = ((ra[0] + ra[2]) + (rb[0] + rb[2])) * (1.0f / 256.0f), ex2 = ((ra[1] + ra[3]) + (rb[1] + rb[3])) * (1.0f / 256.0f);
                const float rstd = 1.0f / sqrtf(fmaxf(ex2 - mean * mean, 0.f) + EPS);
                bf16_t* gp = RG + (size_t)(r0 + cb + i) * 1024 + h * 256 + e;
                *gp = (bf16_t)f2bf((acc[i] - mean) * rstd * gg * bf2f(*gp));
            }
        }
    }
}

constexpr int R3_QP = 272, R3_VP = 576, R3_TP = 528;
constexpr int R3_A_OFF = 0, R3_B_OFF = 128 * R3_QP, R3_ST_OFF = R3_B_OFF + 128 * R3_VP;
static_assert(256 * R3_QP <= 128 * R3_VP && R3_ST_OFF + 2048 <= SCR_BYTES && 128 * R3_TP <= R3_ST_OFF, "R3 LDS map");
__device__ __forceinline__ void p4_retout(const Frame& F, const Ptrs& P, bf16_t* Y1) {
    unsigned char* ws = P.ws;
    const bf16_t* RQ = (const bf16_t*)(ws + WS_RQ); const bf16_t* RK = (const bf16_t*)(ws + WS_RK); const bf16_t* RV = (const bf16_t*)(ws + WS_RV); const bf16_t* RG = (const bf16_t*)(ws + WS_RG);
    const bf16_t* S = (const bf16_t*)((unsigned char*)P.out + 64 * MiB);
    const int tid = F.tid, lane = F.lane, wave = F.wave, r32 = lane & 31, hh = lane >> 5;
    const int eh = wave >> 2, cg = wave < 4 ? wave : 7 - wave;
    LAS unsigned char* Al = F.lds + R3_A_OFF; LAS unsigned char* Bl = F.lds + R3_B_OFF; LAS f32x2* stats = (LAS f32x2*)(F.lds + R3_ST_OFF);
    const LAS unsigned char* vtr = Bl + ((lane & 15) >> 2) * R3_VP + (16 * ((lane >> 4) & 1) + 4 * (lane & 3)) * 2;
    for (int task = blockIdx.x; task < NB * RH * NCH; task += F.G) {
        const int n = task & (NCH - 1), h = (task >> 6) & 3, b = task >> 8; const int r0 = b * SEQ + n * RC;
        const float lg = ret_log2_gamma(h);
        __syncthreads();
        for (int i = tid; i < 128 * 16; i += 512) { const int s = i >> 4, ch = i & 15; *(LAS u32x4*)(Al + s * R3_QP + ch * 16) = *(const u32x4*)(RQ + (size_t)(r0 + s) * 512 + h * 128 + ch * 8); }
        for (int i = tid; i < 256 * 16; i += 512) { const int e = i >> 4, ch = i & 15; *(LAS u32x4*)(Bl + e * R3_QP + ch * 16) = *(const u32x4*)(S + ((size_t)task * 256 + e) * 128 + ch * 8); }
        __syncthreads();
        bf16x8 qf[8];
#pragma unroll
        for (int ks = 0; ks < 8; ++ks) qf[ks] = *(const LAS bf16x8*)(Al + (32 * cg + r32) * R3_QP + (16 * ks + 8 * hh) * 2);
        f32x16 acc[4];
#pragma unroll
        for (int et = 0; et < 4; ++et) {
            f32x16 a;
#pragma unroll
            for (int r = 0; r < 16; ++r) a[r] = 0.f;
            const LAS unsigned char* sp = Bl + (128 * eh + 32 * et + r32) * R3_QP + 16 * hh;
#pragma unroll
            for (int ks = 0; ks < 8; ++ks) a = MFMA32(*(const LAS bf16x8*)(sp + 32 * ks), qf[ks], a);
            acc[et] = a;
        }
        const int c = 32 * cg + r32;
        { const float qd = exp2f(lg * (float)(c + 1));
#pragma unroll
          for (int et = 0; et < 4; ++et)
#pragma unroll
              for (int r = 0; r < 16; ++r) acc[et][r] *= qd; }
        __syncthreads();
        for (int i = tid; i < 128 * 16; i += 512) { const int s = i >> 4, ch = i & 15; *(LAS u32x4*)(Al + s * R3_QP + ch * 16) = *(const u32x4*)(RK + (size_t)(r0 + s) * 512 + h * 128 + ch * 8); }
        for (int i = tid; i < 128 * 32; i += 512) { const int s = i >> 5, ch = i & 31; *(LAS u32x4*)(Bl + s * R3_VP + ch * 16) = *(const u32x4*)(RV + (size_t)(r0 + s) * 1024 + h * 256 + ch * 8); }
        __syncthreads();
#pragma unroll 1
        for (int st = 0; st <= cg; ++st) {
            f32x16 x;
#pragma unroll
            for (int r = 0; r < 16; ++r) x[r] = 0.f;
            const LAS unsigned char* kp = Al + (32 * st + r32) * R3_QP + 16 * hh;
#pragma unroll
            for (int ks = 0; ks < 8; ++ks) x = MFMA32(*(const LAS bf16x8*)(kp + 32 * ks), qf[ks], x);
#pragma unroll
            for (int r = 0; r < 16; ++r) { const int dl = c - (32 * st + crow(r, hh)); x[r] = dl >= 0 ? x[r] * exp2f(lg * (float)dl) : 0.f; }
#pragma unroll
            for (int s2 = 0; s2 < 2; ++s2) {
                const bf16x8 pb = pack8(x, s2);
                const int k0 = 32 * st + 16 * s2 + 4 * hh;
#pragma unroll
                for (int et = 0; et < 4; ++et) acc[et] = MFMA32(tr_frag(vtr, R3_VP, k0, k0 + 8, 128 * eh + 32 * et), pb, acc[et]);
            }
        }
        float s1 = 0.f;
#pragma unroll
        for (int et = 0; et < 4; ++et)
#pragma unroll
            for (int r = 0; r < 16; ++r) s1 += acc[et][r];
        s1 += __shfl_xor(s1, 32);
        const float mw = s1 * (1.0f / 128.0f);
        float q2 = 0.f;
#pragma unroll
        for (int et = 0; et < 4; ++et)
#pragma unroll
            for (int r = 0; r < 16; ++r) { const float d = acc[et][r] - mw; q2 += d * d; }
        q2 += __shfl_xor(q2, 32);
        if (hh == 0) stats[c * 2 + eh] = (f32x2){mw, q2};
        __syncthreads();
        const f32x2 sa = stats[c * 2], sb = stats[c * 2 + 1];
        const float mean = 0.5f * (sa.x + sb.x), dm = sb.x - sa.x;
        const float rstd = 1.0f / sqrtf((sa.y + sb.y + dm * dm * 64.0f) * (1.0f / 256.0f) + EPS);
#pragma unroll
        for (int et = 0; et < 4; ++et)
#pragma unroll
            for (int g = 0; g < 4; ++g) {
                u32x2 w; w.x = cvtpk((acc[et][4 * g] - mean) * rstd, (acc[et][4 * g + 1] - mean) * rstd); w.y = cvtpk((acc[et][4 * g + 2] - mean) * rstd, (acc[et][4 * g + 3] - mean) * rstd);
                *(LAS u32x2*)(Al + c * R3_TP + (128 * eh + 32 * et + 8 * g + 4 * hh) * 2) = w;
            }
        __syncthreads();
#pragma unroll
        for (int i = 0; i < 8; ++i) {
            const int chunk = i * 512 + tid, cc = chunk >> 5, e8 = (chunk & 31) * 8;
            float v[8], gg[8], rg[8]; ldbf8((const LAS bf16_t*)(Al + cc * R3_TP + e8 * 2), v); ld8(P.rg_g + h * 256 + e8, gg);
            const size_t go = (size_t)(r0 + cc) * 1024 + h * 256 + e8; ldbf8(RG + go, rg);
#pragma unroll
            for (int j = 0; j < 8; ++j) v[j] = v[j] * gg[j] * rg[j];
            st8(Y1 + go, v);
        }
    }
}

template <bool DRY> __device__ __forceinline__ void p9_final_norm(const Frame& F, const Ptrs& P) {
    const int gw = F.vcu * NWAVES + F.wave, NGW = F.G * NWAVES;
    f32x4 gv[4];
#pragma unroll
    for (int j = 0; j < 4; ++j) gv[j] = *((const f32x4*)P.lnf_g + F.lane + 64 * j);
    for (int m = gw; m < M; m += NGW) {
        f32x4* xr = (f32x4*)(P.out + (size_t)m * D) + F.lane;
        f32x4 v[4]; float s = 0.f;
#pragma unroll
        for (int j = 0; j < 4; ++j) { v[j] = xr[64 * j]; s += (v[j].x * v[j].x + v[j].y * v[j].y) + (v[j].z * v[j].z + v[j].w * v[j].w); }
        const float rn = rsqrtf_(wave_sum(s) * (1.0f / D) + EPS);
#pragma unroll
        for (int j = 0; j < 4; ++j) xr[64 * j] = DRY ? v[j] * ((rn * gv[j] - 1.0f) * P.fz + 1.0f) : v[j] * rn * gv[j];
    }
}

constexpr int PER_PHASE = 10;
constexpr int N_LAUNCHES = MK_N_LAUNCHES;
struct Args { const float* in[14]; float* out; unsigned char* ws; int ph_lo, ph_hi, li; float fz; };

__global__ void __launch_bounds__(NWAVES * 64, 2) fwd_kernel(Args args) {
    extern __shared__ __attribute__((aligned(16))) unsigned char lds[];
    Frame F;
    F.lds = (LAS unsigned char*)lds;
    F.MISC = (volatile LAS unsigned*)(F.lds + MISC_OFF);
    F.tid = threadIdx.x; F.lane = F.tid & 63; F.wave = __builtin_amdgcn_readfirstlane(F.tid >> 6);
    F.G = gridDim.x; { const int bx = blockIdx.x; F.vcu = (F.G % 8 == 0) ? (bx % 8) * (F.G / 8) + bx / 8 : bx; }
    unsigned char* ws = args.ws;
    F.ctl = (gu32*)(ws + WS_CTL);
    Ptrs P; P.x = args.in[0]; P.b_in = args.in[3]; P.rg_g = args.in[4]; P.sinks = args.in[6]; P.lnf_g = args.in[13]; P.out = args.out; P.ws = ws; P.fz = args.fz;
    for (int u = F.tid; u < (LDS_BYTES - LDSCTL_OFF) / 4; u += NWAVES * 64) ((LAS unsigned*)(F.lds + LDSCTL_OFF))[u] = 0u;
    __syncthreads();
    XcdBarrier bar; bar.bar = (unsigned*)(F.ctl + CW_BAR); bar.x = 0; bar.st = nullptr;
    if (N_LAUNCHES == 1) bar = xcd_barrier_post((unsigned*)(F.ctl + CW_BAR), F.MISC + 8);
#define GRID_BAR() do { if (N_LAUNCHES == 1) xcd_barrier(bar); } while (0)
    const int lo = args.ph_lo, hi = args.ph_hi;
#define IN(k) (lo <= (k) && (k) < hi)
#define BOTH(k) (IN(k) && IN((k) + 1))
    using namespace pg8;
#define REP(k) for (int rep_ = (MK_DUP == (k)) ? 0 : 1; rep_ < 2; ++rep_)
    if (IN(0)) { REP(0) p0_prologue(F, args.in, P);
        if (MK_DUP == 20) { for (int i = 0; i < 10; ++i) GRID_BAR(); }
        if (BOTH(0)) GRID_BAR(); }
    if (IN(1)) {
        Gemm g{(const bf16_t*)P.out, (const bf16_t*)(ws + WS_W1), nullptr, nullptr, D}; StaticOrder S; S.init(M, DIN, F.G, (int)blockIdx.x);
        Epi1 E{P}; gemm_phase<Epi1, StaticOrder, true, true, 1>(F.lds + RING_OFF, g, S, E);
        if (BOTH(1)) GRID_BAR();
    }
    if (IN(2)) {
        if (MK_DUP == 2) p2_attention(F, P, (bf16_t*)((unsigned char*)P.out + 64 * MiB));
        p2_attention(F, P, (bf16_t*)(ws + WS_AQ));
        REP(12) p2_retkv(F, P);
        if (BOTH(2)) GRID_BAR(); }
    if (IN(3)) { REP(3) p3_scan(F, P); if (BOTH(3)) GRID_BAR(); }
    if (IN(4)) { if (MK_DUP == 4) p4_retout(F, P, (bf16_t*)P.out); p4_retout(F, P, (bf16_t*)(ws + WS_RG)); if (BOTH(4)) GRID_BAR(); }
    if (IN(5)) {
        Gemm g{(const bf16_t*)(ws + WS_RG), (const bf16_t*)(ws + WS_WR), (const bf16_t*)(ws + WS_AQ), (const bf16_t*)(ws + WS_WA), D}; DualOrder S; S.init(M, D, F.G, (int)blockIdx.x);
        Epi2 E{P}; REP(5) gemm_phase<Epi2, DualOrder, true, true>(F.lds + RING_OFF, g, S, E);
        if (BOTH(5)) GRID_BAR();
    }
    if (IN(6)) {
        Gemm g{(const bf16_t*)(ws + WS_MG), (const bf16_t*)(ws + WS_WO), nullptr, nullptr, D}; StaticOrder S; S.init(M, D, F.G, (int)blockIdx.x);
        Epi3 E{P}; REP(6) gemm_phase<Epi3, StaticOrder, true, true, 6>(F.lds + RING_OFF, g, S, E);
        if (BOTH(6)) GRID_BAR();
    }
    if (IN(7)) {
        Gemm g{(const bf16_t*)(ws + WS_X1B), (const bf16_t*)(ws + WS_WGU), nullptr, nullptr, D}; StaticOrder S; S.init(M, NGU, F.G, (int)blockIdx.x);
        Epi4 E{P}; REP(7) gemm_phase<Epi4, StaticOrder, true, true, 7>(F.lds + RING_OFF, g, S, E);
        if (BOTH(7)) GRID_BAR();
    }
    if (IN(8)) {
        Gemm g{(const bf16_t*)(ws + WS_ACT), (const bf16_t*)(ws + WS_WD), nullptr, nullptr, DFF}; StaticOrder S; S.init(M, D, F.G, (int)blockIdx.x);
        if (MK_DUP == 8) { Epi5<true> E0{P}; gemm_phase<Epi5<true>, StaticOrder, true, true>(F.lds + RING_OFF, g, S, E0); }
        Epi5<false> E{P}; gemm_phase<Epi5<false>, StaticOrder, true, true>(F.lds + RING_OFF, g, S, E);
        if (BOTH(8)) GRID_BAR();
    }
    if (IN(9)) { if (MK_DUP == 9) p9_final_norm<true>(F, P); p9_final_norm<false>(F, P); }
#undef REP
#undef IN
#undef BOTH
}

extern "C" void kernel_launch(void* const* d_in, const int* in_sizes, int n_in, void* d_out, int out_size, void* d_ws, size_t ws_size, hipStream_t stream) {
    static int grid = 0;
    if (grid == 0) {
        if (n_in != 14 || in_sizes[0] != M * D || out_size != M * D || ws_size < WS_END) { fprintf(stderr, "kernel_launch: unexpected shapes (n_in %d, in0 %d, out %d, ws %zu); nothing launched\n", n_in, n_in > 0 ? in_sizes[0] : -1, out_size, ws_size); grid = -1; return; }
        int dev = 0, cus = 0, per_cu = 0;
        if (hipGetDevice(&dev) != hipSuccess || hipDeviceGetAttribute(&cus, hipDeviceAttributeMultiprocessorCount, dev) != hipSuccess) { grid = -1; return; }
        if (hipFuncSetAttribute((const void*)fwd_kernel, hipFuncAttributeMaxDynamicSharedMemorySize, LDS_BYTES) != hipSuccess) { fprintf(stderr, "kernel_launch: hipFuncSetAttribute failed\n"); grid = -1; return; }
        if (hipOccupancyMaxActiveBlocksPerMultiprocessor(&per_cu, (const void*)fwd_kernel, NWAVES * 64, LDS_BYTES) != hipSuccess || per_cu < 1) { fprintf(stderr, "kernel_launch: occupancy query says %d blocks per CU\n", per_cu); }
        (void)hipGetLastError();
        grid = cus;
    }
    if (grid < 0) return;
    (void)hipMemsetAsync((char*)d_ws + WS_CTL, 0, CTL_ZERO_BYTES, stream);
    Args a{};
    for (int i = 0; i < 14; ++i) a.in[i] = (const float*)d_in[i];
    a.out = (float*)d_out; a.ws = (unsigned char*)d_ws;
    for (int li = 0; li < N_LAUNCHES; ++li) {
        a.ph_lo = (N_LAUNCHES == 1) ? 0 : li; a.ph_hi = (N_LAUNCHES == 1) ? PER_PHASE : li + 1; a.li = li;
        hipLaunchKernelGGL(fwd_kernel, dim3(grid), dim3(NWAVES * 64), LDS_BYTES, stream, a);
    }
}
```
